# Optimizing an MI355X kernel written in HIP

```python
import math
import jax, jax.numpy as jnp
from jax import lax
import numpy as np

D_MODEL = 1024
BATCH = 4
SEQ = 8192
DEPTH = 1

NORM_EPS = 1e-6
NEG_INF = -1e30

CHUNK = 128
GMLP_WIDTH = D_MODEL
GMLP_GROUPS = 8
GMLP_GROUP_DIM = GMLP_WIDTH // GMLP_GROUPS

ATTN_PATTERNS = ((128, 1), (512, 4), (2048, 16))
N_ATTN_GROUPS = len(ATTN_PATTERNS)
ATTN_HEADS = 8
HEAD_DIM = 64
ATTN_GROUP_WIDTH = ATTN_HEADS * HEAD_DIM
QKV_WIDTH = N_ATTN_GROUPS * ATTN_GROUP_WIDTH
ATTN_OUT_WIDTH = ATTN_GROUP_WIDTH
Q_BLOCK = 128

IN_WIDTH = 2 * GMLP_WIDTH + 3 * QKV_WIDTH + 2 * D_MODEL

D_FF = int(math.ceil(8 * D_MODEL / 3 / 256)) * 256

kernel_name = 'hybrid_gmlp_dilated_attn_block'


def rms_norm(x, g):
    x32 = x.astype(jnp.float32)
    y = x32 * lax.rsqrt(jnp.mean(x32 * x32, axis=-1, keepdims=True) + NORM_EPS)
    return (y * g.astype(jnp.float32)).astype(x.dtype)


def alibi_slopes():
    n = N_ATTN_GROUPS * ATTN_HEADS
    i = jnp.arange(1, n + 1, dtype=jnp.float32)
    return jnp.exp2(-8.0 * i / n).reshape(N_ATTN_GROUPS, ATTN_HEADS)


def spatial_gating(u, v, ln_g, ln_b, ws, bs):
    b, s, _ = u.shape
    u32 = jax.nn.gelu(u.astype(jnp.float32), approximate=False)
    v32 = jax.nn.gelu(v.astype(jnp.float32), approximate=False)
    mean = jnp.mean(v32, axis=-1, keepdims=True)
    var = jnp.mean(jnp.square(v32 - mean), axis=-1, keepdims=True)
    vn = (v32 - mean) * lax.rsqrt(var + NORM_EPS) * ln_g.astype(jnp.float32) + ln_b.astype(jnp.float32)
    vc = vn.reshape(b, s // CHUNK, CHUNK, GMLP_GROUPS, GMLP_GROUP_DIM)
    mixed = jnp.einsum('gts,bnsgc->bntgc', ws.astype(jnp.float32), vc)
    mixed = mixed + bs.astype(jnp.float32).T[:, :, None]
    return (u32 * mixed.reshape(b, s, GMLP_WIDTH)).astype(u.dtype)


def dilated_window_attention(q, k, v, window, dilation, slopes):
    b, s, h, dh = q.shape
    half = window // (2 * dilation)
    length = s // dilation
    n_blk = -(-length // Q_BLOCK)
    padded = n_blk * Q_BLOCK

    def to_sub(t):
        t = t.astype(jnp.float32).reshape(b, length, dilation, h, dh).transpose(0, 2, 1, 3, 4)
        return jnp.pad(t, ((0, 0), (0, 0), (0, padded - length), (0, 0), (0, 0)))

    def neighbours(t):
        tp = jnp.pad(t, ((0, 0), (0, 0), (Q_BLOCK, Q_BLOCK), (0, 0), (0, 0)))
        views = [tp[:, :, o * Q_BLOCK:o * Q_BLOCK + padded].reshape(b, dilation, n_blk, Q_BLOCK, h, dh)
                 for o in range(3)]
        return jnp.concatenate(views, axis=3)

    qb = to_sub(q).reshape(b, dilation, n_blk, Q_BLOCK, h, dh)
    kb = neighbours(to_sub(k))
    vb = neighbours(to_sub(v))

    qi = jnp.arange(Q_BLOCK)[:, None]
    kj = jnp.arange(3 * Q_BLOCK)[None, :]
    rel = kj - Q_BLOCK - qi
    key_idx = jnp.arange(n_blk)[:, None, None] * Q_BLOCK + (kj - Q_BLOCK)[None]
    valid = (jnp.abs(rel) <= half)[None] & (key_idx >= 0) & (key_idx < length)
    dist = (jnp.abs(rel) * dilation).astype(jnp.float32)

    scores = jnp.einsum('brnqhe,brnkhe->brnhqk', qb, kb) * (1.0 / math.sqrt(dh))
    scores = scores - slopes[:, None, None] * dist
    scores = jnp.where(valid[:, None], scores, NEG_INF)
    lse = jax.nn.logsumexp(scores, axis=-1)
    probs = jnp.exp(scores - lse[..., None])
    out = jnp.einsum('brnhqk,brnkhe->brnqhe', probs, vb)

    out = out.reshape(b, dilation, padded, h, dh)[:, :, :length]
    out = out.transpose(0, 2, 1, 3, 4).reshape(b, s, h, dh)
    lse = lse.transpose(0, 1, 2, 4, 3).reshape(b, dilation, padded, h)[:, :, :length]
    lse = lse.transpose(0, 2, 1, 3).reshape(b, s, h)
    return out, lse


def dilated_attention_mixer(q, k, v):
    b, s, _ = q.shape
    shp = (b, s, N_ATTN_GROUPS, ATTN_HEADS, HEAD_DIM)
    q, k, v = q.reshape(shp), k.reshape(shp), v.reshape(shp)
    slopes = alibi_slopes()
    outs, lses = [], []
    for g, (window, dil) in enumerate(ATTN_PATTERNS):
        o, l = dilated_window_attention(q[:, :, g], k[:, :, g], v[:, :, g], window, dil, slopes[g])
        outs.append(o)
        lses.append(l)
    outs = jnp.stack(outs, axis=0)
    weights = jax.nn.softmax(jnp.stack(lses, axis=0), axis=0)
    y = jnp.sum(weights[..., None] * outs, axis=0)
    return y.reshape(b, s, ATTN_OUT_WIDTH)


def swiglu(x, w_gate, w_up, w_down):
    return (jax.nn.silu(x @ w_gate) * (x @ w_up)) @ w_down


def setup_inputs(seed: int = 0) -> dict:
    key = jax.random.key(seed)
    ks = jax.random.split(key, 16)
    f32 = jnp.float32
    nrm = lambda k, shape, scale: jax.random.normal(k, shape, f32) * scale
    return {
        'x': jax.random.normal(ks[0], (BATCH, SEQ, D_MODEL), f32),
        'norm_mix_g': 1.0 + nrm(ks[1], (DEPTH, D_MODEL), 0.02),
        'w_in': nrm(ks[2], (DEPTH, D_MODEL, IN_WIDTH), D_MODEL ** -0.5),
        'gmlp_ln_g': 1.0 + nrm(ks[3], (DEPTH, GMLP_WIDTH), 0.02),
        'gmlp_ln_b': nrm(ks[4], (DEPTH, GMLP_WIDTH), 0.02),
        'gmlp_ws': nrm(ks[5], (DEPTH, GMLP_GROUPS, CHUNK, CHUNK), 0.5 * CHUNK ** -0.5),
        'gmlp_bs': 1.0 + nrm(ks[6], (DEPTH, GMLP_GROUPS, CHUNK), 0.1),
        'w_branch_gmlp': nrm(ks[7], (DEPTH, GMLP_WIDTH, D_MODEL), GMLP_WIDTH ** -0.5),
        'w_branch_attn': nrm(ks[8], (DEPTH, ATTN_OUT_WIDTH, D_MODEL), ATTN_OUT_WIDTH ** -0.5),
        'w_out': nrm(ks[9], (DEPTH, D_MODEL, D_MODEL), D_MODEL ** -0.5),
        'norm_ffn_g': 1.0 + nrm(ks[10], (DEPTH, D_MODEL), 0.02),
        'w_ffn_gate': nrm(ks[11], (DEPTH, D_MODEL, D_FF), D_MODEL ** -0.5),
        'w_ffn_up': nrm(ks[12], (DEPTH, D_MODEL, D_FF), D_MODEL ** -0.5),
        'w_ffn_down': nrm(ks[13], (DEPTH, D_FF, D_MODEL), D_FF ** -0.5),
        'norm_final_g': 1.0 + nrm(ks[14], (D_MODEL,), 0.02),
    }


def reference(x, norm_mix_g, w_in, gmlp_ln_g, gmlp_ln_b, gmlp_ws, gmlp_bs, w_branch_gmlp,
              w_branch_attn, w_out, norm_ffn_g, w_ffn_gate, w_ffn_up, w_ffn_down, norm_final_g):
    widths = [GMLP_WIDTH, GMLP_WIDTH, QKV_WIDTH, QKV_WIDTH, QKV_WIDTH, D_MODEL, D_MODEL]
    splits = [int(c) for c in np.cumsum(widths)[:-1]]
    h = x
    for l in range(DEPTH):
        xn = rms_norm(h, norm_mix_g[l])
        proj = xn @ w_in[l]
        u, vg, q, k, va, gate_a, gate_b = jnp.split(proj, splits, axis=-1)
        y_gmlp = spatial_gating(u, vg, gmlp_ln_g[l], gmlp_ln_b[l], gmlp_ws[l], gmlp_bs[l])
        y_attn = dilated_attention_mixer(q, k, va).astype(h.dtype)
        merged = (jax.nn.sigmoid(gate_a) * (y_gmlp @ w_branch_gmlp[l])
                  + jax.nn.sigmoid(gate_b) * (y_attn @ w_branch_attn[l]))
        h = h + merged @ w_out[l]
        h = h + swiglu(rms_norm(h, norm_ffn_g[l]), w_ffn_gate[l], w_ffn_up[l], w_ffn_down[l])
    return rms_norm(h, norm_final_g)
```

```cpp
#include <hip/hip_runtime.h>
#include <cstdio>
#include <cstdint>
namespace pg8 {
#define PG8_LAS __attribute__((address_space(3)))
typedef unsigned short bf16_t;
typedef short bf16x8 __attribute__((ext_vector_type(8)));
typedef float f32x4 __attribute__((ext_vector_type(4)));
typedef unsigned u32x4 __attribute__((ext_vector_type(4)));
constexpr int BM = 256, BK = 64, HALF = 128, HTB = HALF * BK * 2  , STAGE_BYTES = 8 * HTB, NXCD = 8, WGM = 8;

__host__ __device__ __forceinline__ int lds_byte(int r, int c) { const int st = (r >> 4) * 2 + (c >> 5), rr = r & 15, cc = c & 31, ob = rr * 64 + cc * 2; return st * 1024 + (ob ^ (((ob >> 9) & 1) << 5)); }
__host__ __device__ __forceinline__ void stage_rc(int b, int& R, int& C) { const int st = b / 1024, sb = b % 1024, swz = sb ^ (((sb >> 9) & 1) << 5); R = (st >> 1) * 16 + swz / 64; C = (st & 1) * 32 + (swz % 64) / 2; }
__host__ __device__ __forceinline__ int perm32(int rho) { const int n = rho >> 4, i = rho & 15; return 8 * (i >> 2) + 4 * n + (i & 3); }

struct Unit { int pm, pn; };
struct Gemm { const bf16_t* A; const bf16_t* Bt; int M, N, K; };

struct StaticOrder {
    int nM, nN, nwg, G, c;
    __host__ __device__ void init(int M, int N, int G_, int c_) { nM = M / BM; nN = N / BM; nwg = nM * nN; G = G_; c = c_; }
    __host__ __device__ bool next(int i, Unit& u) const {
        const long L = (long)i * G + c; if (L >= nwg) return false;
        int wgid = (int)L; { const int q = nwg / NXCD, r = nwg % NXCD, xcd = wgid % NXCD, off = wgid / NXCD; wgid = (xcd < r ? xcd * (q + 1) : r * (q + 1) + (xcd - r) * q) + off; }
        const int nig = WGM * nN, gid = wgid / nig, fm = gid * WGM, gsz = (nM - fm) < WGM ? (nM - fm) : WGM;
        u.pm = fm + ((wgid % nig) % gsz); u.pn = (wgid % nig) / gsz; return true;
    }
    __device__ __forceinline__ void a_ready(const Unit&) const {}
    __device__ __forceinline__ void done(const Unit&) const {}
};

__device__ __forceinline__ unsigned cvt_pk_bf16(float lo, float hi) { unsigned r; asm volatile("v_cvt_pk_bf16_f32 %0, %1, %2" : "=v"(r) : "v"(lo), "v"(hi)); return r; }
typedef float f32x2 __attribute__((ext_vector_type(2)));
__device__ __forceinline__ f32x2 gelu_pk(f32x2 v) {
    const f32x2 av = __builtin_elementwise_abs(v), d = av * 0.2316418882f + 1.0f;
    f32x2 t; t.x = __builtin_amdgcn_rcpf(d.x); t.y = __builtin_amdgcn_rcpf(d.y);
    f32x2 q = t * 0.5307027145f + (-0.7265760135f); q = q * t + 0.7107068705f; q = q * t + (-0.142248368f); q = q * t + 0.127414796f; q = q * t;
    const f32x2 s = (v * v) * (-0.72134752044f);
    f32x2 e; e.x = __builtin_amdgcn_exp2f(s.x); e.y = __builtin_amdgcn_exp2f(s.y);
    const f32x2 m = v * (q * e), r = v - m;
    f32x2 o; o.x = v.x < 0.f ? m.x : r.x; o.y = v.y < 0.f ? m.y : r.y; return o;
}


__device__ __forceinline__ float sigmoid_f(float x) { return __builtin_amdgcn_rcpf(1.0f + __builtin_amdgcn_exp2f(-1.4426950408889634f * x)); }
__device__ __forceinline__ float bf_lo(unsigned w) { return __uint_as_float(w << 16); }
__device__ __forceinline__ float bf_hi(unsigned w) { return __uint_as_float(w & 0xffff0000u); }
constexpr float QK_C2 = 0.125f * 1.4426950408889634f;

struct EpiProj {
    static constexpr bool PERM = true, AFTER_DRAIN = false; static constexpr int HOOK_T = -1;
    bf16_t* RB;
    __device__ __forceinline__ void hook(f32x4 (&)[2][2][4][2], const Unit&, int, int, int, int) const {}
    __device__ __forceinline__ void operator()(const f32x4 (&acc)[2][2][4][2], const Unit& u, int wr, int wc, int fr, int fq) const {
        asm volatile("" : "+v"(fr), "+v"(fq));
        const int pn = u.pn, row0 = u.pm * BM + wr * 64 + fr;
        if (pn < 8) {
            bf16_t* base = RB + (size_t)(pn >> 2) * (32u << 20); const int col0 = (pn & 3) * BM + wc * 32 + 8 * fq;
#pragma unroll
            for (int ai = 0; ai < 2; ++ai)
#pragma unroll
                for (int m = 0; m < 4; ++m) { bf16_t* rowp = base + (size_t)(row0 + ai * HALF + m * 16) * 1024 + col0;
#pragma unroll
                    for (int bj = 0; bj < 2; ++bj) { const f32x4 v0 = acc[ai][bj][m][0], v1 = acc[ai][bj][m][1];
                        const f32x2 a = gelu_pk((f32x2){v0[0], v0[1]}), b = gelu_pk((f32x2){v0[2], v0[3]}), c = gelu_pk((f32x2){v1[0], v1[1]}), d = gelu_pk((f32x2){v1[2], v1[3]});
                        u32x4 w; w.x = cvt_pk_bf16(a.x, a.y); w.y = cvt_pk_bf16(b.x, b.y); w.z = cvt_pk_bf16(c.x, c.y); w.w = cvt_pk_bf16(d.x, d.y);
                        *(u32x4*)(rowp + bj * HALF) = w; } }
        } else {
            const int t6 = pn - 8, which = t6 / 6, rem = t6 - which * 6, g = rem >> 1, half = rem & 1, dlog = 2 * g;
            bf16_t* base = RB + (size_t)(64u << 20) + (size_t)which * (48u << 20); const float sc = which == 0 ? QK_C2 : 1.0f;
#pragma unroll
            for (int bj = 0; bj < 2; ++bj) { const int cg = half * 256 + bj * HALF + wc * 32 + 8 * fq, h = cg >> 6, dd = cg & 63;
#pragma unroll
                for (int ai = 0; ai < 2; ++ai)
#pragma unroll
                    for (int m = 0; m < 4; ++m) { const int row = row0 + ai * HALF + m * 16, b = row >> 13, t = row & 8191, r = t & ((1 << dlog) - 1), l = t >> dlog;
                        const size_t hr = (size_t)(((g * 4 + b) * 8 + h) * 8192 + r * (8192 >> dlog) + l);
                        const f32x4 v0 = acc[ai][bj][m][0] * sc, v1 = acc[ai][bj][m][1] * sc;
                        u32x4 w; w.x = cvt_pk_bf16(v0[0], v0[1]); w.y = cvt_pk_bf16(v0[2], v0[3]); w.z = cvt_pk_bf16(v1[0], v1[1]); w.w = cvt_pk_bf16(v1[2], v1[3]);
                        *(u32x4*)(base + hr * 64 + dd) = w; } }
        }
    }
};

struct EpiGate {
    static constexpr bool PERM = true, AFTER_DRAIN = false; static constexpr int HOOK_T = -1;
    bf16_t* SG;
    __device__ __forceinline__ void hook(f32x4 (&)[2][2][4][2], const Unit&, int, int, int, int) const {}
    __device__ __forceinline__ void operator()(const f32x4 (&acc)[2][2][4][2], const Unit& u, int wr, int wc, int fr, int fq) const {
        asm volatile("" : "+v"(fr), "+v"(fq));
        const int row0 = u.pm * BM + wr * 64 + fr, j0 = u.pn * HALF + wc * 32 + 8 * fq;
#pragma unroll
        for (int ai = 0; ai < 2; ++ai)
#pragma unroll
            for (int m = 0; m < 4; ++m) { bf16_t* rowp = SG + (size_t)(row0 + ai * HALF + m * 16) * 2048 + j0;
                float rr[8], sb[8];
#pragma unroll
                for (int n = 0; n < 2; ++n)
#pragma unroll
                    for (int i = 0; i < 4; ++i) { const float ea = __builtin_amdgcn_exp2f(-1.4426950408889634f * acc[ai][0][m][n][i]), eb = __builtin_amdgcn_exp2f(-1.4426950408889634f * acc[ai][1][m][n][i]);
                        const float s = __builtin_amdgcn_rcpf(1.0f + eb); sb[n * 4 + i] = s; rr[n * 4 + i] = (1.0f + eb) * __builtin_amdgcn_rcpf(1.0f + ea); }
                u32x4 w; w.x = cvt_pk_bf16(rr[0], rr[1]); w.y = cvt_pk_bf16(rr[2], rr[3]); w.z = cvt_pk_bf16(rr[4], rr[5]); w.w = cvt_pk_bf16(rr[6], rr[7]);
                *(u32x4*)(rowp) = w;
                u32x4 x; x.x = cvt_pk_bf16(sb[0], sb[1]); x.y = cvt_pk_bf16(sb[2], sb[3]); x.z = cvt_pk_bf16(sb[4], sb[5]); x.w = cvt_pk_bf16(sb[6], sb[7]);
                *(u32x4*)(rowp + 1024) = x; }
    }
};

struct EpiMerge {
    static constexpr bool PERM = true, AFTER_DRAIN = false; static constexpr int HOOK_T = 16;
    const bf16_t* SG; bf16_t* O;
    __device__ __forceinline__ void hook(f32x4 (&acc)[2][2][4][2], const Unit& u, int wr, int wc, int fr, int fq) const {
        asm volatile("" : "+v"(fr), "+v"(fq));
        const int row0 = u.pm * BM + wr * 64 + fr, col0 = u.pn * BM + wc * 32 + 8 * fq;
#pragma unroll
        for (int ai = 0; ai < 2; ++ai)
#pragma unroll
            for (int m = 0; m < 4; ++m) { const bf16_t* rowp = SG + (size_t)(row0 + ai * HALF + m * 16) * 2048 + col0;
#pragma unroll
                for (int bj = 0; bj < 2; ++bj) { const u32x4 w = *(const u32x4*)(rowp + bj * HALF);
                    acc[ai][bj][m][0] = acc[ai][bj][m][0] * (f32x4){bf_lo(w.x), bf_hi(w.x), bf_lo(w.y), bf_hi(w.y)};
                    acc[ai][bj][m][1] = acc[ai][bj][m][1] * (f32x4){bf_lo(w.z), bf_hi(w.z), bf_lo(w.w), bf_hi(w.w)}; } }
    }
    __device__ __forceinline__ void operator()(const f32x4 (&acc)[2][2][4][2], const Unit& u, int wr, int wc, int fr, int fq) const {
        asm volatile("" : "+v"(fr), "+v"(fq));
        const int row0 = u.pm * BM + wr * 64 + fr, col0 = u.pn * BM + wc * 32 + 8 * fq;
#pragma unroll
        for (int ai = 0; ai < 2; ++ai)
#pragma unroll
            for (int m = 0; m < 4; ++m) { const size_t row = (size_t)(row0 + ai * HALF + m * 16);
#pragma unroll
                for (int bj = 0; bj < 2; ++bj) { const u32x4 w = *(const u32x4*)(SG + row * 2048 + 1024 + col0 + bj * HALF);
                    const f32x4 v0 = acc[ai][bj][m][0] * (f32x4){bf_lo(w.x), bf_hi(w.x), bf_lo(w.y), bf_hi(w.y)};
                    const f32x4 v1 = acc[ai][bj][m][1] * (f32x4){bf_lo(w.z), bf_hi(w.z), bf_lo(w.w), bf_hi(w.w)};
                    u32x4 o; o.x = cvt_pk_bf16(v0[0], v0[1]); o.y = cvt_pk_bf16(v0[2], v0[3]); o.z = cvt_pk_bf16(v1[0], v1[1]); o.w = cvt_pk_bf16(v1[2], v1[3]);
                    *(u32x4*)(O + row * 1024 + col0 + bj * HALF) = o; } }
    }
};

struct EpiRes {
    static constexpr bool PERM = false, AFTER_DRAIN = false; static constexpr int HOOK_T = -1;
    const float* base; float* out; bf16_t* outb; float* SQ;
    __device__ __forceinline__ void hook(f32x4 (&)[2][2][4][2], const Unit&, int, int, int, int) const {}
    __device__ __forceinline__ void operator()(const f32x4 (&acc)[2][2][4][2], const Unit& u, int wr, int wc, int fr, int fq) const {
        typedef unsigned u32x2v __attribute__((ext_vector_type(2)));
        asm volatile("" : "+v"(fr), "+v"(fq));
        const int row0 = u.pm * BM + wr * 64 + fr, col0 = u.pn * BM + wc * 32 + 4 * fq;
#pragma unroll
        for (int ai = 0; ai < 2; ++ai)
#pragma unroll
            for (int m = 0; m < 4; ++m) { const int row = row0 + ai * HALF + m * 16; const size_t off = (size_t)row * 1024 + col0; float ss = 0.f;
#pragma unroll
                for (int bj = 0; bj < 2; ++bj)
#pragma unroll
                    for (int n = 0; n < 2; ++n) { const size_t o2 = off + bj * HALF + n * 16; const f32x4 h = *(const f32x4*)(base + o2) + acc[ai][bj][m][n];
                        *(f32x4*)(out + o2) = h; ss += (h[0] * h[0] + h[1] * h[1]) + (h[2] * h[2] + h[3] * h[3]);
                        if (outb) { u32x2v w; w.x = cvt_pk_bf16(h[0], h[1]); w.y = cvt_pk_bf16(h[2], h[3]); *(u32x2v*)(outb + o2) = w; } }
                ss += __shfl_xor(ss, 16); ss += __shfl_xor(ss, 32);
                if (fq == 0) SQ[(size_t)row * 16 + u.pn * 4 + wc] = ss; }
    }
};

struct EpiSwiglu {
    static constexpr bool PERM = true, AFTER_DRAIN = false; static constexpr int HOOK_T = -1;
    const float* SQ; bf16_t* ACT; float eps;
    __device__ __forceinline__ void hook(f32x4 (&)[2][2][4][2], const Unit&, int, int, int, int) const {}
    __device__ __forceinline__ void operator()(const f32x4 (&acc)[2][2][4][2], const Unit& u, int wr, int wc, int fr, int fq) const {
        asm volatile("" : "+v"(fr), "+v"(fq));
        const int row0 = u.pm * BM + wr * 64 + fr, j0 = u.pn * HALF + wc * 32 + 8 * fq;
#pragma unroll
        for (int ai = 0; ai < 2; ++ai)
#pragma unroll
            for (int m = 0; m < 4; ++m) { const int row = row0 + ai * HALF + m * 16;
                const f32x4 p4 = *(const f32x4*)(SQ + (size_t)row * 16 + 4 * fq); float ss = (p4[0] + p4[1]) + (p4[2] + p4[3]);
                ss += __shfl_xor(ss, 16); ss += __shfl_xor(ss, 32);
                const float rstd = 1.0f / sqrtf(ss * (1.0f / 1024.0f) + eps);
                float o[8];
#pragma unroll
                for (int n = 0; n < 2; ++n)
#pragma unroll
                    for (int i = 0; i < 4; ++i) { const float gt = acc[ai][0][m][n][i] * rstd, up = acc[ai][1][m][n][i] * rstd; o[n * 4 + i] = gt * sigmoid_f(gt) * up; }
                u32x4 w; w.x = cvt_pk_bf16(o[0], o[1]); w.y = cvt_pk_bf16(o[2], o[3]); w.z = cvt_pk_bf16(o[4], o[5]); w.w = cvt_pk_bf16(o[6], o[7]);
                *(u32x4*)(ACT + (size_t)row * 2816 + j0) = w; }
    }
};

struct GateOrder {
    StaticOrder S1;
    __host__ __device__ void init(int M, int G_, int c_) { S1.init(M, 1024, G_, c_); }
    __host__ __device__ bool next(int i, Unit& u) const { Unit t; if (!S1.next(i >> 1, t)) return false; u.pm = t.pm; u.pn = 2 * t.pn + (i & 1); return true; }
    __device__ __forceinline__ void a_ready(const Unit&) const {}
    __device__ __forceinline__ void done(const Unit&) const {}
};

template <class Epi, class Sched, bool ALIGN_EPI = false, bool SP2 = false>
__device__ __forceinline__ void gemm_phase(PG8_LAS unsigned char* lds, const Gemm g, const Sched& S, const Epi& E) {
    const int tid = threadIdx.x, wid = __builtin_amdgcn_readfirstlane(tid >> 6), lane = tid & 63, wr = wid >> 2, wc = wid & 3, fr = lane & 15, fq = lane >> 4;
    const int K = g.K, nt = K / BK;
    unsigned voffA[2], voffB[2];
#pragma unroll
    for (int i = 0; i < 2; ++i) { int R, C; stage_rc(tid * 16 + i * 8192, R, C); const int Rb = Epi::PERM ? ((R & ~31) + perm32(R & 31)) : R;
        voffA[i] = (unsigned)(R * K + C) * 2u; voffB[i] = (unsigned)(Rb * K + C) * 2u; }
    const size_t kstep = (size_t)(BK * 2);
    const size_t hstep = (size_t)HALF * K * 2;
    const size_t tstep = 2 * hstep;
    const unsigned ldsw = (unsigned)wid * 1024u;
    const int aoff = lds_byte(wr * 64 + fr, fq * 8), boff = lds_byte(wc * 32 + fr, fq * 8);
#define PG8_SA(b, h) (((b) * 2 + (h)) * HTB)
#define PG8_SB(b, h) ((4 + (b) * 2 + (h)) * HTB)
#define PG8_STAGE(bufoff, gbase, voff) do { _Pragma("unroll") for (int _i = 0; _i < 2; ++_i) \
        __builtin_amdgcn_global_load_lds((const unsigned*)((const char*)(gbase) + (voff)[_i]), (PG8_LAS unsigned*)(lds + (bufoff) + ldsw + _i * 8192), 16, 0, 0); } while (0)
#define PG8_LDA(dst, b, h) do { _Pragma("unroll") for (int m = 0; m < 4; ++m) _Pragma("unroll") for (int k = 0; k < 2; ++k) dst[m][k] = *(const PG8_LAS bf16x8*)(lds + PG8_SA(b, h) + aoff + m * 2048 + k * 1024); } while (0)
#define PG8_LDB(dst, b, h) do { _Pragma("unroll") for (int n = 0; n < 2; ++n) _Pragma("unroll") for (int k = 0; k < 2; ++k) dst[n][k] = *(const PG8_LAS bf16x8*)(lds + PG8_SB(b, h) + boff + n * 2048 + k * 1024); } while (0)
#define PG8_MMA(ai, bj, At, Bt) do { __builtin_amdgcn_s_setprio(1); _Pragma("unroll") for (int m = 0; m < 4; ++m) _Pragma("unroll") for (int n = 0; n < 2; ++n) _Pragma("unroll") for (int k = 0; k < 2; ++k) \
        acc[ai][bj][m][n] = __builtin_amdgcn_mfma_f32_16x16x32_bf16(Bt[n][k], At[m][k], acc[ai][bj][m][n], 0, 0, 0); __builtin_amdgcn_s_setprio(0); } while (0)
#define PG8_WAIT_V(n) asm volatile("s_waitcnt vmcnt(" #n ")" ::: "memory")
#define PG8_WAIT_L(n) asm volatile("s_waitcnt lgkmcnt(" #n ")" ::: "memory")
#define PG8_BAR __builtin_amdgcn_s_barrier()
#define PG8_SCHED __builtin_amdgcn_sched_barrier(0)
    Unit cur, nxt; int ui = 0;
    if (!S.next(0, cur)) return;
    f32x4 acc[2][2][4][2];
#pragma unroll
    for (int a = 0; a < 2; ++a)
#pragma unroll
        for (int b = 0; b < 2; ++b)
#pragma unroll
            for (int m = 0; m < 4; ++m)
#pragma unroll
                for (int n = 0; n < 2; ++n) acc[a][b][m][n] = (f32x4){0.f, 0.f, 0.f, 0.f};
    bf16x8 At[4][2], B0[2][2], B1[2][2];
    const char* cA = (const char*)g.A + (size_t)cur.pm * tstep; const char* cB = (const char*)g.Bt + (size_t)cur.pn * tstep;
    S.a_ready(cur);
    if constexpr (SP2) {
        PG8_STAGE(PG8_SB(0, 0), cB, voffB); PG8_STAGE(PG8_SB(0, 1), cB + hstep, voffB); PG8_STAGE(PG8_SA(0, 0), cA, voffA); PG8_STAGE(PG8_SA(0, 1), cA + hstep, voffA);
        if (wr == 1) PG8_BAR;
        PG8_WAIT_V(2); PG8_BAR;
        PG8_STAGE(PG8_SB(1, 0), cB + kstep, voffB); PG8_STAGE(PG8_SA(1, 0), cA + kstep, voffA); PG8_STAGE(PG8_SB(1, 1), cB + hstep + kstep, voffB);
        PG8_WAIT_V(6); PG8_BAR;
    } else {
        PG8_STAGE(PG8_SB(0, 0), cB, voffB); PG8_STAGE(PG8_SA(0, 0), cA, voffA); PG8_STAGE(PG8_SB(0, 1), cB + hstep, voffB); PG8_STAGE(PG8_SA(0, 1), cA + hstep, voffA);
        if (wr == 1) PG8_BAR;
        PG8_WAIT_V(4); PG8_BAR;
        PG8_STAGE(PG8_SB(1, 0), cB + kstep, voffB); PG8_STAGE(PG8_SA(1, 0), cA + kstep, voffA); PG8_STAGE(PG8_SB(1, 1), cB + hstep + kstep, voffB);
        PG8_WAIT_V(6); PG8_BAR;
    }
    for (;;) {
        const bool has_next = S.next(ui + 1, nxt);
        const char* nA = has_next ? (const char*)g.A + (size_t)nxt.pm * tstep : cA; const char* nB = has_next ? (const char*)g.Bt + (size_t)nxt.pn * tstep : cB;
        for (int t = 0; t < nt; t += 2) {
            if constexpr (Epi::HOOK_T >= 0) { if (t == Epi::HOOK_T) E.hook(acc, cur, wr, wc, fr, fq); }
            const bool last = (t == nt - 2);
            const char* a1 = cA + (size_t)(t + 1) * kstep;
            const char* a2 = last ? nA : cA + (size_t)(t + 2) * kstep; const char* b2 = last ? nB : cB + (size_t)(t + 2) * kstep;
            const char* a3 = a2 + kstep; const char* b3 = b2 + kstep;
            if (last && has_next) S.a_ready(nxt);
            if constexpr (SP2) {
            PG8_LDB(B0, 0, 0); PG8_LDB(B1, 0, 1); PG8_SCHED; PG8_LDA(At, 0, 0); PG8_STAGE(PG8_SA(1, 1), a1 + hstep, voffA);
            PG8_WAIT_V(8); PG8_WAIT_L(0); PG8_BAR; PG8_MMA(0, 0, At, B0); PG8_MMA(0, 1, At, B1); PG8_BAR; PG8_SCHED;
            PG8_LDA(At, 0, 1); PG8_STAGE(PG8_SB(0, 0), b2, voffB); PG8_STAGE(PG8_SB(0, 1), b2 + hstep, voffB); PG8_STAGE(PG8_SA(0, 0), a2, voffA);
            PG8_WAIT_V(8); PG8_WAIT_L(0); PG8_BAR; PG8_MMA(1, 0, At, B0); PG8_MMA(1, 1, At, B1); PG8_BAR; PG8_SCHED;
            PG8_LDB(B0, 1, 0); PG8_LDB(B1, 1, 1); PG8_SCHED; PG8_LDA(At, 1, 0); PG8_STAGE(PG8_SA(0, 1), a2 + hstep, voffA);
            PG8_WAIT_V(8); PG8_WAIT_L(0); PG8_BAR; PG8_MMA(0, 0, At, B0); PG8_MMA(0, 1, At, B1); PG8_BAR; PG8_SCHED;
            PG8_LDA(At, 1, 1); PG8_STAGE(PG8_SB(1, 0), b3, voffB); PG8_STAGE(PG8_SB(1, 1), b3 + hstep, voffB); PG8_STAGE(PG8_SA(1, 0), a3, voffA);
            PG8_WAIT_V(8); PG8_WAIT_L(0); PG8_BAR; PG8_MMA(1, 0, At, B0); PG8_MMA(1, 1, At, B1); PG8_BAR; PG8_SCHED;
            } else {
            PG8_LDB(B0, 0, 0); PG8_SCHED; PG8_LDA(At, 0, 0); PG8_STAGE(PG8_SA(1, 1), a1 + hstep, voffA);
            PG8_WAIT_L(8); PG8_BAR; PG8_WAIT_L(0); PG8_MMA(0, 0, At, B0); PG8_BAR; PG8_SCHED;
            PG8_LDB(B1, 0, 1); PG8_STAGE(PG8_SB(0, 0), b2, voffB);
            PG8_BAR; PG8_WAIT_L(0); PG8_MMA(0, 1, At, B1); PG8_BAR;
            PG8_LDA(At, 0, 1); PG8_STAGE(PG8_SA(0, 0), a2, voffA);
            PG8_BAR; PG8_WAIT_L(0); PG8_MMA(1, 0, At, B0); PG8_BAR; PG8_SCHED;
            PG8_STAGE(PG8_SB(0, 1), b2 + hstep, voffB);
            PG8_WAIT_V(6); PG8_BAR; PG8_MMA(1, 1, At, B1); PG8_BAR;
            PG8_LDB(B0, 1, 0); PG8_SCHED; PG8_LDA(At, 1, 0); PG8_STAGE(PG8_SA(0, 1), a2 + hstep, voffA);
            PG8_WAIT_L(8); PG8_BAR; PG8_WAIT_L(0); PG8_MMA(0, 0, At, B0); PG8_BAR; PG8_SCHED;
            PG8_LDB(B1, 1, 1); PG8_STAGE(PG8_SB(1, 0), b3, voffB);
            PG8_BAR; PG8_WAIT_L(0); PG8_MMA(0, 1, At, B1); PG8_BAR;
            PG8_LDA(At, 1, 1); PG8_STAGE(PG8_SA(1, 0), a3, voffA);
            PG8_BAR; PG8_WAIT_L(0); PG8_MMA(1, 0, At, B0); PG8_BAR; PG8_SCHED;
            PG8_STAGE(PG8_SB(1, 1), b3 + hstep, voffB);
            PG8_WAIT_V(6); PG8_BAR; PG8_MMA(1, 1, At, B1); PG8_BAR;
            }
        }
        if constexpr (ALIGN_EPI) { if (wr == 0) PG8_BAR; }
        if constexpr (!Epi::AFTER_DRAIN) { E(acc, cur, wr, wc, fr, fq); S.done(cur); }
        if (!has_next) break;
#pragma unroll
        for (int a = 0; a < 2; ++a)
#pragma unroll
            for (int b = 0; b < 2; ++b)
#pragma unroll
                for (int m = 0; m < 4; ++m)
#pragma unroll
                    for (int n = 0; n < 2; ++n) acc[a][b][m][n] = (f32x4){0.f, 0.f, 0.f, 0.f};
        cur = nxt; cA = nA; cB = nB; ++ui;
        if constexpr (ALIGN_EPI) { if (wr == 1) PG8_BAR; }
    }
    PG8_WAIT_V(0);
    if constexpr (!ALIGN_EPI) { if (wr == 0) PG8_BAR; }
    PG8_BAR;
    if constexpr (Epi::AFTER_DRAIN) { E.fused(acc, cur, wr, wc, fr, fq, lds, wid, lane); S.done(cur); }
#undef PG8_SA
#undef PG8_SB
#undef PG8_STAGE
#undef PG8_LDA
#undef PG8_LDB
#undef PG8_MMA
#undef PG8_WAIT_V
#undef PG8_WAIT_L
#undef PG8_BAR
#undef PG8_SCHED
}
}

#define GAS __attribute__((address_space(1)))
#define LAS __attribute__((address_space(3)))
typedef unsigned short bf16;
typedef unsigned v4u __attribute__((ext_vector_type(4)));
typedef float f32x4 __attribute__((ext_vector_type(4)));
typedef short bf16x8 __attribute__((ext_vector_type(8)));
typedef GAS unsigned gu32;
typedef GAS unsigned long long gu64;
#define RLX_AGENT __ATOMIC_RELAXED, __HIP_MEMORY_SCOPE_AGENT
#define LDS_WAIT() asm volatile("s_waitcnt lgkmcnt(0)" ::: "memory")
#define VM_WAIT() asm volatile("s_waitcnt vmcnt(0)" ::: "memory")
__device__ __forceinline__ unsigned long long rt() { return __builtin_amdgcn_s_memrealtime(); }
__device__ __forceinline__ unsigned f2bf(float f) { unsigned u = __builtin_bit_cast(unsigned, f); return (u + 0x7fffu + ((u >> 16) & 1u)) >> 16; }
__device__ __forceinline__ unsigned pk2(float lo, float hi) { return f2bf(lo) | (f2bf(hi) << 16); }

#define XB_TMO      128
#define XB_XCNT(j)  (256  + 64 * (j))
#define XB_XSUB(j)  (1280 + 64 * (j))
#define XB_XGEN(j)  (2304 + 64 * (j))
#define XB_TOP      3328
#define XB_TOPGEN   3392
#define XCD_BAR_WORDS 3456
#define XB_SPIN_CAP (1u << 18)

__device__ __forceinline__ unsigned xb_ld(unsigned* p)              { return __hip_atomic_load(p, __ATOMIC_RELAXED, __HIP_MEMORY_SCOPE_AGENT); }
__device__ __forceinline__ unsigned xb_add(unsigned* p, unsigned v) { return __hip_atomic_fetch_add(p, v, __ATOMIC_RELAXED, __HIP_MEMORY_SCOPE_AGENT); }
__device__ __forceinline__ unsigned xb_xcc_id() { return (unsigned)__builtin_amdgcn_s_getreg((3 << 11) | 20) & 0xFu; }
#define XB_SPIN(cond, bar) do { unsigned _sp = 0; while (cond) { __builtin_amdgcn_s_sleep(1); \
    if ((++_sp & 255u) == 0u) { if (xb_ld(&(bar)[XB_TMO])) break; if (_sp > XB_SPIN_CAP) { atomicAdd(&(bar)[XB_TMO], 1u); break; } } } } while (0)

struct XcdBarrier {
    unsigned* bar; unsigned x;
    volatile LAS unsigned* st;
};

__device__ __forceinline__ XcdBarrier xcd_barrier_post(unsigned* bar, volatile LAS unsigned* st) {
    XcdBarrier b; b.bar = bar; b.x = xb_xcc_id(); b.st = st;
    if (threadIdx.x == 0) (void)xb_add(&bar[XB_XCNT(b.x)], 1u);
    return b;
}
__device__ __forceinline__ void xcd_barrier_complete(unsigned* bar, unsigned x, unsigned& nloc, unsigned& nx) {
    const unsigned G = gridDim.x * gridDim.y * gridDim.z;
    unsigned sum, cnt, mine, sp = 0u;
    for (;;) {
        sum = 0u; cnt = 0u; mine = 0u;
#pragma unroll
        for (unsigned j = 0; j < 16; ++j) { const unsigned c = xb_ld(&bar[XB_XCNT(j)]); sum += c; cnt += (c > 0u) ? 1u : 0u; mine = (j == x) ? c : mine; }
        if (sum == G) break;
        __builtin_amdgcn_s_sleep(1);
        if ((++sp & 255u) == 0u) { if (xb_ld(&bar[XB_TMO])) break; if (sp > XB_SPIN_CAP) { atomicAdd(&bar[XB_TMO], 1u); break; } }
    }
    nloc = mine > 0u ? mine : 1u; nx = cnt > 0u ? cnt : 1u;
}

__device__ __forceinline__ void xcd_barrier(const XcdBarrier& b) {
    asm volatile("s_waitcnt vmcnt(0)" ::: "memory");
    __syncthreads();
    if (threadIdx.x == 0) {
        unsigned* bar = b.bar;
        __builtin_amdgcn_s_waitcnt(0);
        unsigned nloc = b.st[0], nx = b.st[1];
        if (nloc == 0u) { xcd_barrier_complete(bar, b.x, nloc, nx); b.st[0] = nloc; b.st[1] = nx; }
        const unsigned old = xb_add(&bar[XB_XSUB(b.x)], 1u);
        const unsigned gen = old / nloc;
        if (old + 1u == (gen + 1u) * nloc) {
            __builtin_amdgcn_fence(__ATOMIC_RELEASE, "agent");
            asm volatile("s_waitcnt vmcnt(0)" ::: "memory");
            const unsigned og = xb_add(&bar[XB_TOP], 1u);
            const unsigned tg = og / nx;
            if (og + 1u == (tg + 1u) * nx) xb_add(&bar[XB_TOPGEN], 1u);
            else XB_SPIN(xb_ld(&bar[XB_TOPGEN]) == tg, bar);
            __builtin_amdgcn_fence(__ATOMIC_ACQUIRE, "agent");
            xb_add(&bar[XB_XGEN(b.x)], 1u);
            asm volatile("s_waitcnt vmcnt(0)" ::: "memory");
        } else {
            XB_SPIN(xb_ld(&bar[XB_XGEN(b.x)]) == gen, bar);
            __builtin_amdgcn_fence(__ATOMIC_ACQUIRE, "agent");
            asm volatile("s_waitcnt vmcnt(0)" ::: "memory");
        }
    }
    __syncthreads();
}


constexpr int NWAVES = 8;
#ifndef MK_N_LAUNCHES
#define MK_N_LAUNCHES 1
#endif
constexpr int PER_PHASE = 9;
constexpr int N_LAUNCHES = MK_N_LAUNCHES;

constexpr int BATCH = 4, SEQ = 8192, D = 1024, M = BATCH * SEQ, NP1 = 6656, NGATE = 2048, FF = 2816, FF2 = 5632, KCAT = 1536;
constexpr float NORM_EPS = 1e-6f;
constexpr int NHR = 3 * BATCH * 8 * SEQ;

constexpr size_t MiB = 1u << 20;
constexpr size_t WS_CTL = 0, CTL_ZERO_BYTES = 1 * MiB;
constexpr size_t WS_WIN = 2 * MiB;
constexpr size_t WS_WAB = 19 * MiB;
constexpr size_t WS_WOUT = 22 * MiB;
constexpr size_t WS_WGU = 24 * MiB;
constexpr size_t WS_WDN = 35 * MiB;
constexpr size_t WS_GWS = 41 * MiB;
constexpr size_t WS_SQ1 = 42 * MiB;
constexpr size_t WS_SQ2 = 44 * MiB;
constexpr size_t WS_LSE = 46 * MiB;
constexpr size_t WS_R = 50 * MiB;
constexpr size_t WS_U = WS_R, WS_VG = WS_R + 64 * MiB, WS_Q = WS_R + 128 * MiB, WS_K = WS_R + 224 * MiB, WS_V = WS_R + 320 * MiB;
constexpr size_t WS_YCAT = WS_K;
constexpr size_t WS_SG = WS_R;
constexpr size_t WS_MRG = WS_V;
constexpr size_t WS_H1B = WS_K;
constexpr size_t WS_ACT = WS_R;
constexpr size_t WS_END = WS_R + 416 * MiB;

constexpr int RING_OFF = 0, RING_BYTES = 131072;
constexpr int LDSCTL_OFF = RING_BYTES, MISC_OFF = LDSCTL_OFF + 320;
constexpr int LDS_BYTES = 147456;
constexpr int CW_BAR = 4096;

struct Args { const float* in[15]; float* out; unsigned char* ws; int ph_lo, ph_hi; };

struct Frame {
    LAS unsigned char* lds;
    volatile LAS unsigned* MISC;
    gu32* ctl;
    int tid, lane, wave, vcu, G;
};

__device__ __forceinline__ float wave_sum(float v) {
#pragma unroll
    for (int o = 1; o < 64; o <<= 1) v += __shfl_xor(v, o);
    return v;
}
__device__ __forceinline__ float wave_max(float v) {
#pragma unroll
    for (int o = 1; o < 64; o <<= 1) v = fmaxf(v, __shfl_xor(v, o));
    return v;
}
__device__ __forceinline__ float bf2f(unsigned short h) { return __uint_as_float((unsigned)h << 16); }

__device__ __forceinline__ void p0_transpose_item(const float* W, int K, int N, int ncol0, bf16* WT, int ldk, int k_off, int mode, int row_off, const float* kscale, LAS float* scr, int item, int nblk, int lane) {
    const int kb = item / nblk, nb = item % nblk, k0 = 64 * kb, n0 = 32 * nb;
#pragma unroll 8
    for (int i = 0; i < 32; ++i) { const int kk = 2 * i + (lane >> 5); float v = W[(size_t)(k0 + kk) * N + ncol0 + n0 + (lane & 31)]; if (kscale) v *= kscale[k0 + kk]; scr[kk * 33 + (lane & 31)] = v; }
    LDS_WAIT(); asm volatile("" ::: "memory");
    const int c = lane & 7; const int drow0 = mode == 0 ? row_off + n0 : ((n0 >> 7) << 8) + (n0 & 127) + row_off;
#pragma unroll
    for (int j = 0; j < 4; ++j) { const int n = (lane >> 3) + 8 * j; const LAS float* s = scr + (8 * c) * 33 + n;
        v4u o; o.x = pk2(s[0 * 33], s[1 * 33]); o.y = pk2(s[2 * 33], s[3 * 33]); o.z = pk2(s[4 * 33], s[5 * 33]); o.w = pk2(s[6 * 33], s[7 * 33]);
        *(GAS v4u*)(WT + (size_t)(drow0 + n) * ldk + k_off + k0 + 8 * c) = o; }
    LDS_WAIT(); asm volatile("" ::: "memory");
}
__device__ __forceinline__ void p0_prologue(Frame& F, const Args& a) {
    unsigned char* ws = a.ws;
    LAS float* scr = (LAS float*)(F.lds + RING_OFF + F.wave * 16384);
    const int gw = F.vcu * NWAVES + F.wave, NGW = F.G * NWAVES;
    constexpr int I_P1 = 16 * (NP1 / 32), I_G = 16 * (1024 / 32), I_A = 16 * 32, I_B = 8 * 32, I_O = 16 * 32, I_F = 16 * (FF / 32), I_D = (FF / 64) * 32;
    constexpr int NITEMS = I_P1 + 2 * I_G + I_A + I_B + I_O + 2 * I_F + I_D;
    const float* w_in = a.in[2];
    for (int it = gw; it < NITEMS; it += NGW) {
        int r = it;
        if (r < I_P1) { p0_transpose_item(w_in, D, 8704, 0, (bf16*)(ws + WS_WIN), D, 0, 0, 0, nullptr, scr, r, NP1 / 32, F.lane); continue; } r -= I_P1;
        if (r < I_G) { p0_transpose_item(w_in, D, 8704, 6656, (bf16*)(ws + WS_WIN), D, 0, 1, 6656, nullptr, scr, r, 32, F.lane); continue; } r -= I_G;
        if (r < I_G) { p0_transpose_item(w_in, D, 8704, 7680, (bf16*)(ws + WS_WIN), D, 0, 1, 6656 + 128, nullptr, scr, r, 32, F.lane); continue; } r -= I_G;
        if (r < I_A) { p0_transpose_item(a.in[7], 1024, 1024, 0, (bf16*)(ws + WS_WAB), KCAT, 0, 0, 0, nullptr, scr, r, 32, F.lane); continue; } r -= I_A;
        if (r < I_B) { p0_transpose_item(a.in[8], 512, 1024, 0, (bf16*)(ws + WS_WAB), KCAT, 1024, 0, 0, nullptr, scr, r, 32, F.lane); continue; } r -= I_B;
        if (r < I_O) { p0_transpose_item(a.in[9], 1024, 1024, 0, (bf16*)(ws + WS_WOUT), D, 0, 0, 0, nullptr, scr, r, 32, F.lane); continue; } r -= I_O;
        if (r < I_F) { p0_transpose_item(a.in[11], D, FF, 0, (bf16*)(ws + WS_WGU), D, 0, 1, 0, a.in[10], scr, r, FF / 32, F.lane); continue; } r -= I_F;
        if (r < I_F) { p0_transpose_item(a.in[12], D, FF, 0, (bf16*)(ws + WS_WGU), D, 0, 1, 128, a.in[10], scr, r, FF / 32, F.lane); continue; } r -= I_F;
        p0_transpose_item(a.in[13], FF, D, 0, (bf16*)(ws + WS_WDN), FF, 0, 0, 0, nullptr, scr, r, 32, F.lane);
    }
    { const float* gws = a.in[5]; bf16* o = (bf16*)(ws + WS_GWS); const int gt = F.vcu * (NWAVES * 64) + F.tid, NT = F.G * NWAVES * 64;
      for (int i = gt; i < 8 * 128 * 128 / 2; i += NT) ((GAS unsigned*)o)[i] = pk2(gws[2 * i], gws[2 * i + 1]); }
    { const float* x = a.in[0]; const float* g = a.in[1]; bf16* XN = (bf16*)a.out;
      f32x4 gv[4];
#pragma unroll
      for (int j = 0; j < 4; ++j) gv[j] = *((const GAS f32x4*)g + F.lane + 64 * j);
      for (int m = gw; m < M; m += NGW) {
        const GAS f32x4* xr = (const GAS f32x4*)(x + (size_t)m * D) + F.lane; f32x4 v[4]; float s = 0.f;
#pragma unroll
        for (int j = 0; j < 4; ++j) { v[j] = xr[64 * j]; s += (v[j].x * v[j].x + v[j].y * v[j].y) + (v[j].z * v[j].z + v[j].w * v[j].w); }
        const float rstd = 1.f / sqrtf(wave_sum(s) * (1.f / D) + NORM_EPS);
        GAS unsigned long long* o8 = (GAS unsigned long long*)(XN + (size_t)m * D) + F.lane;
#pragma unroll
        for (int j = 0; j < 4; ++j) o8[64 * j] = (unsigned long long)pk2(v[j].x * rstd * gv[j].x, v[j].y * rstd * gv[j].y) | ((unsigned long long)pk2(v[j].z * rstd * gv[j].z, v[j].w * rstd * gv[j].w) << 32);
      } }
}

__device__ __forceinline__ void attn_simple(Frame& F, bf16* Qb, const bf16* Kb, const bf16* Vb, float* LSE) {
    const int gw = F.vcu * NWAVES + F.wave, NGW = F.G * NWAVES, lane = F.lane;
    for (int R = gw; R < NHR; R += NGW) {
        const int g = R >> 18, rem = R & 262143, b = rem >> 16, h = (rem >> 13) & 7, p = rem & 8191;
        const int dlog = 2 * g, L = 8192 >> dlog, l = p & (L - 1), r = p >> (13 - dlog);
        const int seq0 = R - l;
        const float slope2 = __builtin_amdgcn_exp2f(-(float)(g * 8 + h + 1) * (1.0f / 3.0f)) * (float)(1 << dlog) * 1.4426950408889634f;
        float q[64];
        { const GAS v4u* qp = (const GAS v4u*)(Qb + (size_t)R * 64);
#pragma unroll
          for (int c = 0; c < 8; ++c) { const v4u w = qp[c];
            q[8 * c + 0] = __uint_as_float(w.x << 16); q[8 * c + 1] = __uint_as_float(w.x & 0xffff0000u); q[8 * c + 2] = __uint_as_float(w.y << 16); q[8 * c + 3] = __uint_as_float(w.y & 0xffff0000u);
            q[8 * c + 4] = __uint_as_float(w.z << 16); q[8 * c + 5] = __uint_as_float(w.z & 0xffff0000u); q[8 * c + 6] = __uint_as_float(w.w << 16); q[8 * c + 7] = __uint_as_float(w.w & 0xffff0000u); } }
        float s[3]; bool ok[3];
#pragma unroll
        for (int ps = 0; ps < 3; ++ps) {
            const int j = lane + 64 * ps - 64, kl = l + j; ok[ps] = (j <= 64) && (kl >= 0) && (kl < L);
            const int klc = kl < 0 ? 0 : (kl > L - 1 ? L - 1 : kl);
            const GAS v4u* kp = (const GAS v4u*)(Kb + (size_t)(seq0 + klc) * 64); float acc = 0.f;
#pragma unroll
            for (int c = 0; c < 8; ++c) { const v4u w = kp[c];
                acc += q[8 * c + 0] * __uint_as_float(w.x << 16) + q[8 * c + 1] * __uint_as_float(w.x & 0xffff0000u) + q[8 * c + 2] * __uint_as_float(w.y << 16) + q[8 * c + 3] * __uint_as_float(w.y & 0xffff0000u)
                     + q[8 * c + 4] * __uint_as_float(w.z << 16) + q[8 * c + 5] * __uint_as_float(w.z & 0xffff0000u) + q[8 * c + 6] * __uint_as_float(w.w << 16) + q[8 * c + 7] * __uint_as_float(w.w & 0xffff0000u); }
            const float aj = (float)(j < 0 ? -j : j);
            s[ps] = ok[ps] ? acc - slope2 * aj : -1e30f;
        }
        const float mx = wave_max(fmaxf(fmaxf(s[0], s[1]), s[2]));
        float pr[3]; float ls = 0.f;
#pragma unroll
        for (int ps = 0; ps < 3; ++ps) { pr[ps] = ok[ps] ? __builtin_amdgcn_exp2f(s[ps] - mx) : 0.f; ls += pr[ps]; }
        ls = wave_sum(ls);
        float o = 0.f;
#pragma unroll
        for (int ps = 0; ps < 3; ++ps) {
            const int nj = ps == 2 ? 1 : 64;
            for (int jj = 0; jj < nj; ++jj) {
                const float pj = __uint_as_float((unsigned)__builtin_amdgcn_readlane((int)__float_as_uint(pr[ps]), jj));
                int kl = l + jj + 64 * ps - 64; kl = kl < 0 ? 0 : (kl > L - 1 ? L - 1 : kl);
                o += pj * bf2f(Vb[(size_t)(seq0 + kl) * 64 + lane]);
            }
        }
        o = o / ls;
        Qb[(size_t)R * 64 + lane] = (bf16)f2bf(o);
        if (lane == 0) { const int token = b * SEQ + (l << dlog) + r; LSE[((size_t)g * M + token) * 8 + h] = mx + __builtin_amdgcn_logf(ls); }
    }
}

__device__ __forceinline__ void gmlp_merge_simple(Frame& F, const Args& a) {
    unsigned char* ws = a.ws;
    const bf16* U = (const bf16*)(ws + WS_U); const bf16* VG = (const bf16*)(ws + WS_VG); const bf16* Ob = (const bf16*)(ws + WS_Q); const float* LSE = (const float*)(ws + WS_LSE);
    const bf16* GWS = (const bf16*)(ws + WS_GWS); bf16* YC = (bf16*)(ws + WS_YCAT);
    const float* ln_g = a.in[3]; const float* ln_b = a.in[4]; const float* bs = a.in[6];
    LAS float* st = (LAS float*)(F.lds + RING_BYTES + 1024);
    LAS float* vn = (LAS float*)(F.lds);
    LAS float* wsl = (LAS float*)(F.lds + 65536);
    const int tid = F.tid, lane = F.lane, wave = F.wave;
    for (int ci = F.vcu; ci < M / 128; ci += F.G) {
        const int tok0 = ci * 128;
        for (int i = 0; i < 16; ++i) { const int tk = wave * 16 + i; const GAS v4u* rp = (const GAS v4u*)(VG + (size_t)(tok0 + tk) * 1024);
            float v[16];
#pragma unroll
            for (int j = 0; j < 2; ++j) { const v4u w = rp[lane + 64 * j];
                v[8 * j + 0] = __uint_as_float(w.x << 16); v[8 * j + 1] = __uint_as_float(w.x & 0xffff0000u); v[8 * j + 2] = __uint_as_float(w.y << 16); v[8 * j + 3] = __uint_as_float(w.y & 0xffff0000u);
                v[8 * j + 4] = __uint_as_float(w.z << 16); v[8 * j + 5] = __uint_as_float(w.z & 0xffff0000u); v[8 * j + 6] = __uint_as_float(w.w << 16); v[8 * j + 7] = __uint_as_float(w.w & 0xffff0000u); }
            float s = 0.f;
#pragma unroll
            for (int j = 0; j < 16; ++j) s += v[j];
            const float mean = wave_sum(s) * (1.0f / 1024.0f); float q = 0.f;
#pragma unroll
            for (int j = 0; j < 16; ++j) { const float d = v[j] - mean; q += d * d; }
            const float rstd = 1.0f / sqrtf(wave_sum(q) * (1.0f / 1024.0f) + NORM_EPS);
            if (lane == 0) { st[2 * tk] = mean; st[2 * tk + 1] = rstd; } }
        __syncthreads();
        for (int g = 0; g < 8; ++g) {
#pragma unroll
            for (int i = 0; i < 4; ++i) { const int idx = tid + 512 * i, s = idx >> 4, c8 = (idx & 15) * 8;
                const v4u w = *(const GAS v4u*)(VG + (size_t)(tok0 + s) * 1024 + 128 * g + c8); const float mean = st[2 * s], rstd = st[2 * s + 1];
                const float* lg = ln_g + 128 * g + c8; const float* lb = ln_b + 128 * g + c8; LAS float* d = vn + s * 128 + c8;
                d[0] = (__uint_as_float(w.x << 16) - mean) * rstd * lg[0] + lb[0]; d[1] = (__uint_as_float(w.x & 0xffff0000u) - mean) * rstd * lg[1] + lb[1];
                d[2] = (__uint_as_float(w.y << 16) - mean) * rstd * lg[2] + lb[2]; d[3] = (__uint_as_float(w.y & 0xffff0000u) - mean) * rstd * lg[3] + lb[3];
                d[4] = (__uint_as_float(w.z << 16) - mean) * rstd * lg[4] + lb[4]; d[5] = (__uint_as_float(w.z & 0xffff0000u) - mean) * rstd * lg[5] + lb[5];
                d[6] = (__uint_as_float(w.w << 16) - mean) * rstd * lg[6] + lb[6]; d[7] = (__uint_as_float(w.w & 0xffff0000u) - mean) * rstd * lg[7] + lb[7];
                const v4u x = *(const GAS v4u*)(GWS + (size_t)g * 16384 + (size_t)s * 128 + c8); LAS float* e = wsl + s * 128 + c8;
                e[0] = __uint_as_float(x.x << 16); e[1] = __uint_as_float(x.x & 0xffff0000u); e[2] = __uint_as_float(x.y << 16); e[3] = __uint_as_float(x.y & 0xffff0000u);
                e[4] = __uint_as_float(x.z << 16); e[5] = __uint_as_float(x.z & 0xffff0000u); e[6] = __uint_as_float(x.w << 16); e[7] = __uint_as_float(x.w & 0xffff0000u); }
            __syncthreads();
            const int c = tid & 127, tq = tid >> 7;
            float acc[32];
#pragma unroll
            for (int tt = 0; tt < 32; ++tt) acc[tt] = 0.f;
            for (int s = 0; s < 128; s += 4) {
                const float v0 = vn[(s + 0) * 128 + c], v1 = vn[(s + 1) * 128 + c], v2 = vn[(s + 2) * 128 + c], v3 = vn[(s + 3) * 128 + c];
#pragma unroll
                for (int tt = 0; tt < 32; ++tt) { const f32x4 w4 = *(const LAS f32x4*)(wsl + (32 * tq + tt) * 128 + s); acc[tt] += w4.x * v0 + w4.y * v1 + w4.z * v2 + w4.w * v3; }
            }
#pragma unroll
            for (int tt = 0; tt < 32; ++tt) { const int t = 32 * tq + tt; const size_t tok = (size_t)(tok0 + t);
                const float uu = bf2f(U[tok * 1024 + 128 * g + c]); YC[tok * KCAT + 128 * g + c] = (bf16)f2bf(uu * (acc[tt] + bs[g * 128 + t])); }
            __syncthreads();
        }
        for (int i = 0; i < 128; ++i) { const int idx = tid + 512 * i, tk = idx >> 9, ch = idx & 511, h = ch >> 6, dd = ch & 63; const int token = tok0 + tk, b = token >> 13, t = token & 8191;
            float ls[3], ov[3];
#pragma unroll
            for (int g = 0; g < 3; ++g) { const int dlog = 2 * g, r = t & ((1 << dlog) - 1), l = t >> dlog; const size_t hr = (size_t)(((g * 4 + b) * 8 + h) * 8192 + r * (8192 >> dlog) + l);
                ov[g] = bf2f(Ob[hr * 64 + dd]); ls[g] = LSE[((size_t)g * M + token) * 8 + h]; }
            const float mx = fmaxf(fmaxf(ls[0], ls[1]), ls[2]); const float w0 = __builtin_amdgcn_exp2f(ls[0] - mx), w1 = __builtin_amdgcn_exp2f(ls[1] - mx), w2 = __builtin_amdgcn_exp2f(ls[2] - mx);
            YC[(size_t)token * KCAT + 1024 + ch] = (bf16)f2bf((w0 * ov[0] + w1 * ov[1] + w2 * ov[2]) / (w0 + w1 + w2)); }
        __syncthreads();
    }
}

__device__ __forceinline__ void final_norm(Frame& F, const Args& a) {
    const float* SQ = (const float*)(a.ws + WS_SQ2); const float* g = a.in[14]; float* out = a.out;
    const int gw = F.vcu * NWAVES + F.wave, NGW = F.G * NWAVES;
    f32x4 gv[4];
#pragma unroll
    for (int j = 0; j < 4; ++j) gv[j] = *((const GAS f32x4*)g + F.lane + 64 * j);
    for (int m = gw; m < M; m += NGW) {
        float s = F.lane < 16 ? SQ[(size_t)m * 16 + F.lane] : 0.f; s = wave_sum(s);
        const float rstd = 1.f / sqrtf(s * (1.f / D) + NORM_EPS);
        GAS f32x4* xr = (GAS f32x4*)(out + (size_t)m * D) + F.lane;
#pragma unroll
        for (int j = 0; j < 4; ++j) { const f32x4 v = xr[64 * j]; xr[64 * j] = v * rstd * gv[j]; }
    }
}

__global__ void __launch_bounds__(NWAVES * 64, 2) mk_fwd(Args args) {
    extern __shared__ __attribute__((aligned(16))) unsigned char lds[];
    Frame F;
    F.lds = (LAS unsigned char*)lds;
    F.MISC = (volatile LAS unsigned*)(F.lds + MISC_OFF);
#define REFRAME() do { int t_ = threadIdx.x; asm volatile("" : "+v"(t_)); F.tid = t_; F.lane = t_ & 63; F.wave = __builtin_amdgcn_readfirstlane(t_ >> 6); } while (0)
    REFRAME();
    F.G = gridDim.x; { const int bx = blockIdx.x; F.vcu = (F.G % 8 == 0) ? (bx % 8) * (F.G / 8) + bx / 8 : bx; }
    unsigned char* ws = args.ws;
    F.ctl = (gu32*)(ws + WS_CTL);
    for (int u = F.tid; u < (LDS_BYTES - LDSCTL_OFF) / 4; u += NWAVES * 64) ((LAS unsigned*)(F.lds + LDSCTL_OFF))[u] = 0u;
    __syncthreads();
    XcdBarrier bar; bar.bar = (unsigned*)(F.ctl + CW_BAR); bar.x = 0; bar.st = nullptr;
    if (N_LAUNCHES != PER_PHASE) bar = xcd_barrier_post((unsigned*)(F.ctl + CW_BAR), F.MISC + 8);
#define GRID_BAR() do { if (N_LAUNCHES != PER_PHASE) xcd_barrier(bar); } while (0)
    const int lo = args.ph_lo, hi = args.ph_hi;
#define IN(k) (lo <= (k) && (k) < hi)
#define BOTH(k) (IN(k) && IN((k) + 1))
    bf16* XN = (bf16*)args.out;
    bf16* WIN = (bf16*)(ws + WS_WIN);

    if (IN(0)) { p0_prologue(F, args); if (BOTH(0)) GRID_BAR(); }

    if (IN(1)) {
        pg8::Gemm g{XN, WIN, M, NP1, D}; pg8::StaticOrder S; S.init(M, NP1, F.G, (int)blockIdx.x);
        pg8::EpiProj E{(bf16*)(ws + WS_R)};
        pg8::gemm_phase<pg8::EpiProj, pg8::StaticOrder, true, true>(F.lds + RING_OFF, g, S, E);
        if (BOTH(1)) GRID_BAR();
    }
    if (IN(2)) { REFRAME(); attn_simple(F, (bf16*)(ws + WS_Q), (const bf16*)(ws + WS_K), (const bf16*)(ws + WS_V), (float*)(ws + WS_LSE)); if (BOTH(2)) GRID_BAR(); }
    if (IN(3)) { REFRAME(); gmlp_merge_simple(F, args); if (BOTH(3)) GRID_BAR(); }
    if (IN(4)) {
        { pg8::Gemm g{XN, WIN + (size_t)NP1 * D, M, NGATE, D}; pg8::GateOrder S; S.init(M, F.G, (int)blockIdx.x);
          pg8::EpiGate E{(bf16*)(ws + WS_SG)};
          pg8::gemm_phase<pg8::EpiGate, pg8::GateOrder, true, true>(F.lds + RING_OFF, g, S, E); }
        { pg8::Gemm g{(const bf16*)(ws + WS_YCAT), (const bf16*)(ws + WS_WAB), M, D, KCAT}; pg8::StaticOrder S; S.init(M, D, F.G, (int)blockIdx.x);
          pg8::EpiMerge E{(const bf16*)(ws + WS_SG), (bf16*)(ws + WS_MRG)};
          pg8::gemm_phase<pg8::EpiMerge, pg8::StaticOrder, true, true>(F.lds + RING_OFF, g, S, E); }
        if (BOTH(4)) GRID_BAR();
    }
    if (IN(5)) {
        pg8::Gemm g{(const bf16*)(ws + WS_MRG), (const bf16*)(ws + WS_WOUT), M, D, D}; pg8::StaticOrder S; S.init(M, D, F.G, (int)blockIdx.x);
        pg8::EpiRes E{args.in[0], args.out, (bf16*)(ws + WS_H1B), (float*)(ws + WS_SQ1)};
        pg8::gemm_phase<pg8::EpiRes, pg8::StaticOrder, true, true>(F.lds + RING_OFF, g, S, E);
        if (BOTH(5)) GRID_BAR();
    }
    if (IN(6)) {
        pg8::Gemm g{(const bf16*)(ws + WS_H1B), (const bf16*)(ws + WS_WGU), M, FF2, D}; pg8::StaticOrder S; S.init(M, FF2, F.G, (int)blockIdx.x);
        pg8::EpiSwiglu E{(const float*)(ws + WS_SQ1), (bf16*)(ws + WS_ACT), NORM_EPS};
        pg8::gemm_phase<pg8::EpiSwiglu, pg8::StaticOrder, true, true>(F.lds + RING_OFF, g, S, E);
        if (BOTH(6)) GRID_BAR();
    }
    if (IN(7)) {
        pg8::Gemm g{(const bf16*)(ws + WS_ACT), (const bf16*)(ws + WS_WDN), M, D, FF}; pg8::StaticOrder S; S.init(M, D, F.G, (int)blockIdx.x);
        pg8::EpiRes E{args.out, args.out, nullptr, (float*)(ws + WS_SQ2)};
        pg8::gemm_phase<pg8::EpiRes, pg8::StaticOrder, true, true>(F.lds + RING_OFF, g, S, E);
        if (BOTH(7)) GRID_BAR();
    }
    if (IN(8)) { REFRAME(); final_norm(F, args); }
#undef IN
#undef BOTH
}

extern "C" void kernel_launch(void* const* d_in, const int* in_sizes, int n_in, void* d_out, int out_size, void* d_ws, size_t ws_size, hipStream_t stream) {
    static int grid = 0;
    if (grid == 0) {
        if (n_in != 15 || out_size != M * D || ws_size < WS_END) { fprintf(stderr, "kernel_launch: unexpected shapes: n_in %d out %d ws %zu (need >= %zu)\n", n_in, out_size, ws_size, (size_t)WS_END); grid = -1; return; }
        int dev = 0, cus = 0, per_cu = 0;
        if (hipGetDevice(&dev) != hipSuccess || hipDeviceGetAttribute(&cus, hipDeviceAttributeMultiprocessorCount, dev) != hipSuccess) { grid = -1; return; }
        if (hipFuncSetAttribute((const void*)mk_fwd, hipFuncAttributeMaxDynamicSharedMemorySize, LDS_BYTES) != hipSuccess) { fprintf(stderr, "kernel_launch: hipFuncSetAttribute failed\n"); grid = -1; return; }
        if (hipOccupancyMaxActiveBlocksPerMultiprocessor(&per_cu, (const void*)mk_fwd, NWAVES * 64, LDS_BYTES) != hipSuccess || per_cu < 1)
            fprintf(stderr, "kernel_launch: occupancy query reports %d workgroups per CU\n", per_cu);
        (void)hipGetLastError();
        grid = cus;
    }
    if (grid < 0) return;
    if (hipMemsetAsync((char*)d_ws + WS_CTL, 0, CTL_ZERO_BYTES, stream) != hipSuccess) { fprintf(stderr, "kernel_launch: hipMemsetAsync failed\n"); return; }
    Args a{};
    for (int i = 0; i < 15; ++i) a.in[i] = (const float*)d_in[i];
    a.out = (float*)d_out; a.ws = (unsigned char*)d_ws;
    for (int li = 0; li < N_LAUNCHES; ++li) {
        a.ph_lo = (N_LAUNCHES == PER_PHASE) ? li : 0; a.ph_hi = (N_LAUNCHES == PER_PHASE) ? li + 1 : PER_PHASE;
        hipLaunchKernelGGL(mk_fwd, dim3(grid), dim3(NWAVES * 64), LDS_BYTES, stream, a);
        const hipError_t le = hipPeekAtLastError();
        if (le != hipSuccess) { fprintf(stderr, "kernel_launch: launch %d failed: %s\n", li, hipGetErrorName(le)); break; }
    }
}
```

```cpp
#include <hip/hip_runtime.h>
#include <cstdio>
#include <cstdint>
namespace pg8 {
#define PG8_LAS __attribute__((address_space(3)))
typedef unsigned short bf16_t;
typedef short bf16x8 __attribute__((ext_vector_type(8)));
typedef float f32x4 __attribute__((ext_vector_type(4)));
typedef unsigned u32x4 __attribute__((ext_vector_type(4)));
constexpr int BM = 256, BK = 64, HALF = 128, HTB = HALF * BK * 2  , STAGE_BYTES = 8 * HTB, NXCD = 8, WGM = 8;

__host__ __device__ __forceinline__ int lds_byte(int r, int c) { const int st = (r >> 4) * 2 + (c >> 5), rr = r & 15, cc = c & 31, ob = rr * 64 + cc * 2; return st * 1024 + (ob ^ (((ob >> 9) & 1) << 5)); }
__host__ __device__ __forceinline__ void stage_rc(int b, int& R, int& C) { const int st = b / 1024, sb = b % 1024, swz = sb ^ (((sb >> 9) & 1) << 5); R = (st >> 1) * 16 + swz / 64; C = (st & 1) * 32 + (swz % 64) / 2; }
__host__ __device__ __forceinline__ int perm32(int rho) { const int n = rho >> 4, i = rho & 15; return 8 * (i >> 2) + 4 * n + (i & 3); }

struct Unit { int pm, pn; };
struct Gemm { const bf16_t* A; const bf16_t* Bt; int M, N, K; };

struct StaticOrder {
    int nM, nN, nwg, G, c;
    __host__ __device__ void init(int M, int N, int G_, int c_) { nM = M / BM; nN = N / BM; nwg = nM * nN; G = G_; c = c_; }
    __host__ __device__ bool next(int i, Unit& u) const {
        const long L = (long)i * G + c; if (L >= nwg) return false;
        int wgid = (int)L; { const int q = nwg / NXCD, r = nwg % NXCD, xcd = wgid % NXCD, off = wgid / NXCD; wgid = (xcd < r ? xcd * (q + 1) : r * (q + 1) + (xcd - r) * q) + off; }
        const int nig = WGM * nN, gid = wgid / nig, fm = gid * WGM, gsz = (nM - fm) < WGM ? (nM - fm) : WGM;
        u.pm = fm + ((wgid % nig) % gsz); u.pn = (wgid % nig) / gsz; return true;
    }
    __device__ __forceinline__ void a_ready(const Unit&) const {}
    __device__ __forceinline__ void done(const Unit&) const {}
};

__device__ __forceinline__ unsigned cvt_pk_bf16(float lo, float hi) { unsigned r; asm volatile("v_cvt_pk_bf16_f32 %0, %1, %2" : "=v"(r) : "v"(lo), "v"(hi)); return r; }
typedef float f32x2 __attribute__((ext_vector_type(2)));
__device__ __forceinline__ f32x2 gelu_pk(f32x2 v) {
    const f32x2 av = __builtin_elementwise_abs(v), d = av * 0.2316418882f + 1.0f;
    f32x2 t; t.x = __builtin_amdgcn_rcpf(d.x); t.y = __builtin_amdgcn_rcpf(d.y);
    f32x2 q = t * 0.5307027145f + (-0.7265760135f); q = q * t + 0.7107068705f; q = q * t + (-0.142248368f); q = q * t + 0.127414796f; q = q * t;
    const f32x2 s = (v * v) * (-0.72134752044f);
    f32x2 e; e.x = __builtin_amdgcn_exp2f(s.x); e.y = __builtin_amdgcn_exp2f(s.y);
    const f32x2 m = v * (q * e), r = v - m;
    f32x2 o; o.x = v.x < 0.f ? m.x : r.x; o.y = v.y < 0.f ? m.y : r.y; return o;
}


__device__ __forceinline__ float sigmoid_f(float x) { return __builtin_amdgcn_rcpf(1.0f + __builtin_amdgcn_exp2f(-1.4426950408889634f * x)); }
__device__ __forceinline__ float bf_lo(unsigned w) { return __uint_as_float(w << 16); }
__device__ __forceinline__ float bf_hi(unsigned w) { return __uint_as_float(w & 0xffff0000u); }
constexpr float QK_C2 = 0.125f * 1.4426950408889634f;

struct EpiProj {
    static constexpr bool PERM = true, AFTER_DRAIN = false; static constexpr int HOOK_T = -1;
    bf16_t* RB;
    __device__ __forceinline__ void hook(f32x4 (&)[2][2][4][2], const Unit&, int, int, int, int) const {}
    __device__ __forceinline__ void operator()(const f32x4 (&acc)[2][2][4][2], const Unit& u, int wr, int wc, int fr, int fq) const {
        asm volatile("" : "+v"(fr), "+v"(fq));
        const int pn = u.pn, row0 = u.pm * BM + wr * 64 + fr;
        if (pn < 8) {
            bf16_t* base = RB + (size_t)(pn >> 2) * (32u << 20); const int col0 = (pn & 3) * BM + wc * 32 + 8 * fq;
#pragma unroll
            for (int ai = 0; ai < 2; ++ai)
#pragma unroll
                for (int m = 0; m < 4; ++m) { bf16_t* rowp = base + (size_t)(row0 + ai * HALF + m * 16) * 1024 + col0;
#pragma unroll
                    for (int bj = 0; bj < 2; ++bj) { const f32x4 v0 = acc[ai][bj][m][0], v1 = acc[ai][bj][m][1];
                        const f32x2 a = gelu_pk((f32x2){v0[0], v0[1]}), b = gelu_pk((f32x2){v0[2], v0[3]}), c = gelu_pk((f32x2){v1[0], v1[1]}), d = gelu_pk((f32x2){v1[2], v1[3]});
                        u32x4 w; w.x = cvt_pk_bf16(a.x, a.y); w.y = cvt_pk_bf16(b.x, b.y); w.z = cvt_pk_bf16(c.x, c.y); w.w = cvt_pk_bf16(d.x, d.y);
                        *(u32x4*)(rowp + bj * HALF) = w; } }
        } else {
            const int t6 = pn - 8, which = t6 / 6, rem = t6 - which * 6, g = rem >> 1, half = rem & 1, dlog = 2 * g;
            bf16_t* base = RB + (size_t)(64u << 20) + (size_t)which * (48u << 20); const float sc = which == 0 ? QK_C2 : 1.0f;
#pragma unroll
            for (int bj = 0; bj < 2; ++bj) { const int cg = half * 256 + bj * HALF + wc * 32 + 8 * fq, h = cg >> 6, dd = cg & 63;
#pragma unroll
                for (int ai = 0; ai < 2; ++ai)
#pragma unroll
                    for (int m = 0; m < 4; ++m) { const int row = row0 + ai * HALF + m * 16, b = row >> 13, t = row & 8191, r = t & ((1 << dlog) - 1), l = t >> dlog;
                        const size_t hr = (size_t)(((g * 4 + b) * 8 + h) * 8192 + r * (8192 >> dlog) + l);
                        const f32x4 v0 = acc[ai][bj][m][0] * sc, v1 = acc[ai][bj][m][1] * sc;
                        u32x4 w; w.x = cvt_pk_bf16(v0[0], v0[1]); w.y = cvt_pk_bf16(v0[2], v0[3]); w.z = cvt_pk_bf16(v1[0], v1[1]); w.w = cvt_pk_bf16(v1[2], v1[3]);
                        *(u32x4*)(base + hr * 64 + dd) = w; } }
        }
    }
};

struct EpiGate {
    static constexpr bool PERM = true, AFTER_DRAIN = false; static constexpr int HOOK_T = -1;
    bf16_t* SG;
    __device__ __forceinline__ void hook(f32x4 (&)[2][2][4][2], const Unit&, int, int, int, int) const {}
    __device__ __forceinline__ void operator()(const f32x4 (&acc)[2][2][4][2], const Unit& u, int wr, int wc, int fr, int fq) const {
        asm volatile("" : "+v"(fr), "+v"(fq));
        const int row0 = u.pm * BM + wr * 64 + fr, j0 = u.pn * HALF + wc * 32 + 8 * fq;
#pragma unroll
        for (int ai = 0; ai < 2; ++ai)
#pragma unroll
            for (int m = 0; m < 4; ++m) { bf16_t* rowp = SG + (size_t)(row0 + ai * HALF + m * 16) * 2048 + j0;
                float rr[8], sb[8];
#pragma unroll
                for (int n = 0; n < 2; ++n)
#pragma unroll
                    for (int i = 0; i < 4; ++i) { const float ea = __builtin_amdgcn_exp2f(-1.4426950408889634f * acc[ai][0][m][n][i]), eb = __builtin_amdgcn_exp2f(-1.4426950408889634f * acc[ai][1][m][n][i]);
                        const float s = __builtin_amdgcn_rcpf(1.0f + eb); sb[n * 4 + i] = s; rr[n * 4 + i] = (1.0f + eb) * __builtin_amdgcn_rcpf(1.0f + ea); }
                u32x4 w; w.x = cvt_pk_bf16(rr[0], rr[1]); w.y = cvt_pk_bf16(rr[2], rr[3]); w.z = cvt_pk_bf16(rr[4], rr[5]); w.w = cvt_pk_bf16(rr[6], rr[7]);
                *(u32x4*)(rowp) = w;
                u32x4 x; x.x = cvt_pk_bf16(sb[0], sb[1]); x.y = cvt_pk_bf16(sb[2], sb[3]); x.z = cvt_pk_bf16(sb[4], sb[5]); x.w = cvt_pk_bf16(sb[6], sb[7]);
                *(u32x4*)(rowp + 1024) = x; }
    }
};

struct EpiMerge {
    static constexpr bool PERM = true, AFTER_DRAIN = false; static constexpr int HOOK_T = 16;
    const bf16_t* SG; bf16_t* O;
    __device__ __forceinline__ void hook(f32x4 (&acc)[2][2][4][2], const Unit& u, int wr, int wc, int fr, int fq) const {
        asm volatile("" : "+v"(fr), "+v"(fq));
        const int row0 = u.pm * BM + wr * 64 + fr, col0 = u.pn * BM + wc * 32 + 8 * fq;
#pragma unroll
        for (int ai = 0; ai < 2; ++ai)
#pragma unroll
            for (int m = 0; m < 4; ++m) { const bf16_t* rowp = SG + (size_t)(row0 + ai * HALF + m * 16) * 2048 + col0;
#pragma unroll
                for (int bj = 0; bj < 2; ++bj) { const u32x4 w = *(const u32x4*)(rowp + bj * HALF);
                    acc[ai][bj][m][0] = acc[ai][bj][m][0] * (f32x4){bf_lo(w.x), bf_hi(w.x), bf_lo(w.y), bf_hi(w.y)};
                    acc[ai][bj][m][1] = acc[ai][bj][m][1] * (f32x4){bf_lo(w.z), bf_hi(w.z), bf_lo(w.w), bf_hi(w.w)}; } }
    }
    __device__ __forceinline__ void operator()(const f32x4 (&acc)[2][2][4][2], const Unit& u, int wr, int wc, int fr, int fq) const {
        asm volatile("" : "+v"(fr), "+v"(fq));
        const int row0 = u.pm * BM + wr * 64 + fr, col0 = u.pn * BM + wc * 32 + 8 * fq;
#pragma unroll
        for (int ai = 0; ai < 2; ++ai)
#pragma unroll
            for (int m = 0; m < 4; ++m) { const size_t row = (size_t)(row0 + ai * HALF + m * 16);
#pragma unroll
                for (int bj = 0; bj < 2; ++bj) { const u32x4 w = *(const u32x4*)(SG + row * 2048 + 1024 + col0 + bj * HALF);
                    const f32x4 v0 = acc[ai][bj][m][0] * (f32x4){bf_lo(w.x), bf_hi(w.x), bf_lo(w.y), bf_hi(w.y)};
                    const f32x4 v1 = acc[ai][bj][m][1] * (f32x4){bf_lo(w.z), bf_hi(w.z), bf_lo(w.w), bf_hi(w.w)};
                    u32x4 o; o.x = cvt_pk_bf16(v0[0], v0[1]); o.y = cvt_pk_bf16(v0[2], v0[3]); o.z = cvt_pk_bf16(v1[0], v1[1]); o.w = cvt_pk_bf16(v1[2], v1[3]);
                    *(u32x4*)(O + row * 1024 + col0 + bj * HALF) = o; } }
    }
};

struct EpiRes {
    static constexpr bool PERM = false, AFTER_DRAIN = false; static constexpr int HOOK_T = -1;
    const float* base; float* out; bf16_t* outb; float* SQ;
    __device__ __forceinline__ void hook(f32x4 (&)[2][2][4][2], const Unit&, int, int, int, int) const {}
    __device__ __forceinline__ void operator()(const f32x4 (&acc)[2][2][4][2], const Unit& u, int wr, int wc, int fr, int fq) const {
        typedef unsigned u32x2v __attribute__((ext_vector_type(2)));
        asm volatile("" : "+v"(fr), "+v"(fq));
        const int row0 = u.pm * BM + wr * 64 + fr, col0 = u.pn * BM + wc * 32 + 4 * fq;
#pragma unroll
        for (int ai = 0; ai < 2; ++ai)
#pragma unroll
            for (int m = 0; m < 4; ++m) { const int row = row0 + ai * HALF + m * 16; const size_t off = (size_t)row * 1024 + col0; float ss = 0.f;
#pragma unroll
                for (int bj = 0; bj < 2; ++bj)
#pragma unroll
                    for (int n = 0; n < 2; ++n) { const size_t o2 = off + bj * HALF + n * 16; const f32x4 h = *(const f32x4*)(base + o2) + acc[ai][bj][m][n];
                        *(f32x4*)(out + o2) = h; ss += (h[0] * h[0] + h[1] * h[1]) + (h[2] * h[2] + h[3] * h[3]);
                        if (outb) { u32x2v w; w.x = cvt_pk_bf16(h[0], h[1]); w.y = cvt_pk_bf16(h[2], h[3]); *(u32x2v*)(outb + o2) = w; } }
                ss += __shfl_xor(ss, 16); ss += __shfl_xor(ss, 32);
                if (fq == 0) SQ[(size_t)row * 16 + u.pn * 4 + wc] = ss; }
    }
};

struct EpiSwiglu {
    static constexpr bool PERM = true, AFTER_DRAIN = false; static constexpr int HOOK_T = -1;
    const float* SQ; bf16_t* ACT; float eps;
    __device__ __forceinline__ void hook(f32x4 (&)[2][2][4][2], const Unit&, int, int, int, int) const {}
    __device__ __forceinline__ void operator()(const f32x4 (&acc)[2][2][4][2], const Unit& u, int wr, int wc, int fr, int fq) const {
        asm volatile("" : "+v"(fr), "+v"(fq));
        const int row0 = u.pm * BM + wr * 64 + fr, j0 = u.pn * HALF + wc * 32 + 8 * fq;
#pragma unroll
        for (int ai = 0; ai < 2; ++ai)
#pragma unroll
            for (int m = 0; m < 4; ++m) { const int row = row0 + ai * HALF + m * 16;
                const f32x4 p4 = *(const f32x4*)(SQ + (size_t)row * 16 + 4 * fq); float ss = (p4[0] + p4[1]) + (p4[2] + p4[3]);
                ss += __shfl_xor(ss, 16); ss += __shfl_xor(ss, 32);
                const float rstd = 1.0f / sqrtf(ss * (1.0f / 1024.0f) + eps);
                float o[8];
#pragma unroll
                for (int n = 0; n < 2; ++n)
#pragma unroll
                    for (int i = 0; i < 4; ++i) { const float gt = acc[ai][0][m][n][i] * rstd, up = acc[ai][1][m][n][i] * rstd; o[n * 4 + i] = gt * sigmoid_f(gt) * up; }
                u32x4 w; w.x = cvt_pk_bf16(o[0], o[1]); w.y = cvt_pk_bf16(o[2], o[3]); w.z = cvt_pk_bf16(o[4], o[5]); w.w = cvt_pk_bf16(o[6], o[7]);
                *(u32x4*)(ACT + (size_t)row * 2816 + j0) = w; }
    }
};

struct GateOrder {
    StaticOrder S1;
    __host__ __device__ void init(int M, int G_, int c_) { S1.init(M, 1024, G_, c_); }
    __host__ __device__ bool next(int i, Unit& u) const { Unit t; if (!S1.next(i >> 1, t)) return false; u.pm = t.pm; u.pn = 2 * t.pn + (i & 1); return true; }
    __device__ __forceinline__ void a_ready(const Unit&) const {}
    __device__ __forceinline__ void done(const Unit&) const {}
};

template <class Epi, class Sched, bool ALIGN_EPI = false, bool SP2 = false>
__device__ __forceinline__ void gemm_phase(PG8_LAS unsigned char* lds, const Gemm g, const Sched& S, const Epi& E) {
    const int tid = threadIdx.x, wid = __builtin_amdgcn_readfirstlane(tid >> 6), lane = tid & 63, wr = wid >> 2, wc = wid & 3, fr = lane & 15, fq = lane >> 4;
    const int K = g.K, nt = K / BK;
    unsigned voffA[2], voffB[2];
#pragma unroll
    for (int i = 0; i < 2; ++i) { int R, C; stage_rc(tid * 16 + i * 8192, R, C); const int Rb = Epi::PERM ? ((R & ~31) + perm32(R & 31)) : R;
        voffA[i] = (unsigned)(R * K + C) * 2u; voffB[i] = (unsigned)(Rb * K + C) * 2u; }
    const size_t kstep = (size_t)(BK * 2);
    const size_t hstep = (size_t)HALF * K * 2;
    const size_t tstep = 2 * hstep;
    const unsigned ldsw = (unsigned)wid * 1024u;
    const int aoff = lds_byte(wr * 64 + fr, fq * 8), boff = lds_byte(wc * 32 + fr, fq * 8);
#define PG8_SA(b, h) (((b) * 2 + (h)) * HTB)
#define PG8_SB(b, h) ((4 + (b) * 2 + (h)) * HTB)
#define PG8_STAGE(bufoff, gbase, voff) do { _Pragma("unroll") for (int _i = 0; _i < 2; ++_i) \
        __builtin_amdgcn_global_load_lds((const unsigned*)((const char*)(gbase) + (voff)[_i]), (PG8_LAS unsigned*)(lds + (bufoff) + ldsw + _i * 8192), 16, 0, 0); } while (0)
#define PG8_LDA(dst, b, h) do { _Pragma("unroll") for (int m = 0; m < 4; ++m) _Pragma("unroll") for (int k = 0; k < 2; ++k) dst[m][k] = *(const PG8_LAS bf16x8*)(lds + PG8_SA(b, h) + aoff + m * 2048 + k * 1024); } while (0)
#define PG8_LDB(dst, b, h) do { _Pragma("unroll") for (int n = 0; n < 2; ++n) _Pragma("unroll") for (int k = 0; k < 2; ++k) dst[n][k] = *(const PG8_LAS bf16x8*)(lds + PG8_SB(b, h) + boff + n * 2048 + k * 1024); } while (0)
#define PG8_MMA(ai, bj, At, Bt) do { __builtin_amdgcn_s_setprio(1); _Pragma("unroll") for (int m = 0; m < 4; ++m) _Pragma("unroll") for (int n = 0; n < 2; ++n) _Pragma("unroll") for (int k = 0; k < 2; ++k) \
        acc[ai][bj][m][n] = __builtin_amdgcn_mfma_f32_16x16x32_bf16(Bt[n][k], At[m][k], acc[ai][bj][m][n], 0, 0, 0); __builtin_amdgcn_s_setprio(0); } while (0)
#define PG8_WAIT_V(n) asm volatile("s_waitcnt vmcnt(" #n ")" ::: "memory")
#define PG8_WAIT_L(n) asm volatile("s_waitcnt lgkmcnt(" #n ")" ::: "memory")
#define PG8_BAR __builtin_amdgcn_s_barrier()
#define PG8_SCHED __builtin_amdgcn_sched_barrier(0)
    Unit cur, nxt; int ui = 0;
    if (!S.next(0, cur)) return;
    f32x4 acc[2][2][4][2];
#pragma unroll
    for (int a = 0; a < 2; ++a)
#pragma unroll
        for (int b = 0; b < 2; ++b)
#pragma unroll
            for (int m = 0; m < 4; ++m)
#pragma unroll
                for (int n = 0; n < 2; ++n) acc[a][b][m][n] = (f32x4){0.f, 0.f, 0.f, 0.f};
    bf16x8 At[4][2], B0[2][2], B1[2][2];
    const char* cA = (const char*)g.A + (size_t)cur.pm * tstep; const char* cB = (const char*)g.Bt + (size_t)cur.pn * tstep;
    S.a_ready(cur);
    if constexpr (SP2) {
        PG8_STAGE(PG8_SB(0, 0), cB, voffB); PG8_STAGE(PG8_SB(0, 1), cB + hstep, voffB); PG8_STAGE(PG8_SA(0, 0), cA, voffA); PG8_STAGE(PG8_SA(0, 1), cA + hstep, voffA);
        if (wr == 1) PG8_BAR;
        PG8_WAIT_V(2); PG8_BAR;
        PG8_STAGE(PG8_SB(1, 0), cB + kstep, voffB); PG8_STAGE(PG8_SA(1, 0), cA + kstep, voffA); PG8_STAGE(PG8_SB(1, 1), cB + hstep + kstep, voffB);
        PG8_WAIT_V(6); PG8_BAR;
    } else {
        PG8_STAGE(PG8_SB(0, 0), cB, voffB); PG8_STAGE(PG8_SA(0, 0), cA, voffA); PG8_STAGE(PG8_SB(0, 1), cB + hstep, voffB); PG8_STAGE(PG8_SA(0, 1), cA + hstep, voffA);
        if (wr == 1) PG8_BAR;
        PG8_WAIT_V(4); PG8_BAR;
        PG8_STAGE(PG8_SB(1, 0), cB + kstep, voffB); PG8_STAGE(PG8_SA(1, 0), cA + kstep, voffA); PG8_STAGE(PG8_SB(1, 1), cB + hstep + kstep, voffB);
        PG8_WAIT_V(6); PG8_BAR;
    }
    for (;;) {
        const bool has_next = S.next(ui + 1, nxt);
        const char* nA = has_next ? (const char*)g.A + (size_t)nxt.pm * tstep : cA; const char* nB = has_next ? (const char*)g.Bt + (size_t)nxt.pn * tstep : cB;
        for (int t = 0; t < nt; t += 2) {
            if constexpr (Epi::HOOK_T >= 0) { if (t == Epi::HOOK_T) E.hook(acc, cur, wr, wc, fr, fq); }
            const bool last = (t == nt - 2);
            const char* a1 = cA + (size_t)(t + 1) * kstep;
            const char* a2 = last ? nA : cA + (size_t)(t + 2) * kstep; const char* b2 = last ? nB : cB + (size_t)(t + 2) * kstep;
            const char* a3 = a2 + kstep; const char* b3 = b2 + kstep;
            if (last && has_next) S.a_ready(nxt);
            if constexpr (SP2) {
            PG8_LDB(B0, 0, 0); PG8_LDB(B1, 0, 1); PG8_SCHED; PG8_LDA(At, 0, 0); PG8_STAGE(PG8_SA(1, 1), a1 + hstep, voffA);
            PG8_WAIT_V(8); PG8_WAIT_L(0); PG8_BAR; PG8_MMA(0, 0, At, B0); PG8_MMA(0, 1, At, B1); PG8_BAR; PG8_SCHED;
            PG8_LDA(At, 0, 1); PG8_STAGE(PG8_SB(0, 0), b2, voffB); PG8_STAGE(PG8_SB(0, 1), b2 + hstep, voffB); PG8_STAGE(PG8_SA(0, 0), a2, voffA);
            PG8_WAIT_V(8); PG8_WAIT_L(0); PG8_BAR; PG8_MMA(1, 0, At, B0); PG8_MMA(1, 1, At, B1); PG8_BAR; PG8_SCHED;
            PG8_LDB(B0, 1, 0); PG8_LDB(B1, 1, 1); PG8_SCHED; PG8_LDA(At, 1, 0); PG8_STAGE(PG8_SA(0, 1), a2 + hstep, voffA);
            PG8_WAIT_V(8); PG8_WAIT_L(0); PG8_BAR; PG8_MMA(0, 0, At, B0); PG8_MMA(0, 1, At, B1); PG8_BAR; PG8_SCHED;
            PG8_LDA(At, 1, 1); PG8_STAGE(PG8_SB(1, 0), b3, voffB); PG8_STAGE(PG8_SB(1, 1), b3 + hstep, voffB); PG8_STAGE(PG8_SA(1, 0), a3, voffA);
            PG8_WAIT_V(8); PG8_WAIT_L(0); PG8_BAR; PG8_MMA(1, 0, At, B0); PG8_MMA(1, 1, At, B1); PG8_BAR; PG8_SCHED;
            } else {
            PG8_LDB(B0, 0, 0); PG8_SCHED; PG8_LDA(At, 0, 0); PG8_STAGE(PG8_SA(1, 1), a1 + hstep, voffA);
            PG8_WAIT_L(8); PG8_BAR; PG8_WAIT_L(0); PG8_MMA(0, 0, At, B0); PG8_BAR; PG8_SCHED;
            PG8_LDB(B1, 0, 1); PG8_STAGE(PG8_SB(0, 0), b2, voffB);
            PG8_BAR; PG8_WAIT_L(0); PG8_MMA(0, 1, At, B1); PG8_BAR;
            PG8_LDA(At, 0, 1); PG8_STAGE(PG8_SA(0, 0), a2, voffA);
            PG8_BAR; PG8_WAIT_L(0); PG8_MMA(1, 0, At, B0); PG8_BAR; PG8_SCHED;
            PG8_STAGE(PG8_SB(0, 1), b2 + hstep, voffB);
            PG8_WAIT_V(6); PG8_BAR; PG8_MMA(1, 1, At, B1); PG8_BAR;
            PG8_LDB(B0, 1, 0); PG8_SCHED; PG8_LDA(At, 1, 0); PG8_STAGE(PG8_SA(0, 1), a2 + hstep, voffA);
            PG8_WAIT_L(8); PG8_BAR; PG8_WAIT_L(0); PG8_MMA(0, 0, At, B0); PG8_BAR; PG8_SCHED;
            PG8_LDB(B1, 1, 1); PG8_STAGE(PG8_SB(1, 0), b3, voffB);
            PG8_BAR; PG8_WAIT_L(0); PG8_MMA(0, 1, At, B1); PG8_BAR;
            PG8_LDA(At, 1, 1); PG8_STAGE(PG8_SA(1, 0), a3, voffA);
            PG8_BAR; PG8_WAIT_L(0); PG8_MMA(1, 0, At, B0); PG8_BAR; PG8_SCHED;
            PG8_STAGE(PG8_SB(1, 1), b3 + hstep, voffB);
            PG8_WAIT_V(6); PG8_BAR; PG8_MMA(1, 1, At, B1); PG8_BAR;
            }
        }
        if constexpr (ALIGN_EPI) { if (wr == 0) PG8_BAR; }
        if constexpr (!Epi::AFTER_DRAIN) { E(acc, cur, wr, wc, fr, fq); S.done(cur); }
        if (!has_next) break;
#pragma unroll
        for (int a = 0; a < 2; ++a)
#pragma unroll
            for (int b = 0; b < 2; ++b)
#pragma unroll
                for (int m = 0; m < 4; ++m)
#pragma unroll
                    for (int n = 0; n < 2; ++n) acc[a][b][m][n] = (f32x4){0.f, 0.f, 0.f, 0.f};
        cur = nxt; cA = nA; cB = nB; ++ui;
        if constexpr (ALIGN_EPI) { if (wr == 1) PG8_BAR; }
    }
    PG8_WAIT_V(0);
    if constexpr (!ALIGN_EPI) { if (wr == 0) PG8_BAR; }
    PG8_BAR;
    if constexpr (Epi::AFTER_DRAIN) { E.fused(acc, cur, wr, wc, fr, fq, lds, wid, lane); S.done(cur); }
#undef PG8_SA
#undef PG8_SB
#undef PG8_STAGE
#undef PG8_LDA
#undef PG8_LDB
#undef PG8_MMA
#undef PG8_WAIT_V
#undef PG8_WAIT_L
#undef PG8_BAR
#undef PG8_SCHED
}
}

#define GAS __attribute__((address_space(1)))
#define LAS __attribute__((address_space(3)))
typedef unsigned short bf16;
typedef unsigned v4u __attribute__((ext_vector_type(4)));
typedef float f32x4 __attribute__((ext_vector_type(4)));
typedef short bf16x8 __attribute__((ext_vector_type(8)));
typedef GAS unsigned gu32;
typedef GAS unsigned long long gu64;
#define RLX_AGENT __ATOMIC_RELAXED, __HIP_MEMORY_SCOPE_AGENT
#define LDS_WAIT() asm volatile("s_waitcnt lgkmcnt(0)" ::: "memory")
#define VM_WAIT() asm volatile("s_waitcnt vmcnt(0)" ::: "memory")
__device__ __forceinline__ unsigned long long rt() { return __builtin_amdgcn_s_memrealtime(); }
__device__ __forceinline__ unsigned f2bf(float f) { unsigned u = __builtin_bit_cast(unsigned, f); return (u + 0x7fffu + ((u >> 16) & 1u)) >> 16; }
__device__ __forceinline__ unsigned pk2(float lo, float hi) { return f2bf(lo) | (f2bf(hi) << 16); }

#define XB_TMO      128
#define XB_XCNT(j)  (256  + 64 * (j))
#define XB_XSUB(j)  (1280 + 64 * (j))
#define XB_XGEN(j)  (2304 + 64 * (j))
#define XB_TOP      3328
#define XB_TOPGEN   3392
#define XCD_BAR_WORDS 3456
#define XB_SPIN_CAP (1u << 18)

__device__ __forceinline__ unsigned xb_ld(unsigned* p)              { return __hip_atomic_load(p, __ATOMIC_RELAXED, __HIP_MEMORY_SCOPE_AGENT); }
__device__ __forceinline__ unsigned xb_add(unsigned* p, unsigned v) { return __hip_atomic_fetch_add(p, v, __ATOMIC_RELAXED, __HIP_MEMORY_SCOPE_AGENT); }
__device__ __forceinline__ unsigned xb_xcc_id() { return (unsigned)__builtin_amdgcn_s_getreg((3 << 11) | 20) & 0xFu; }
#define XB_SPIN(cond, bar) do { unsigned _sp = 0; while (cond) { __builtin_amdgcn_s_sleep(1); \
    if ((++_sp & 255u) == 0u) { if (xb_ld(&(bar)[XB_TMO])) break; if (_sp > XB_SPIN_CAP) { atomicAdd(&(bar)[XB_TMO], 1u); break; } } } } while (0)

struct XcdBarrier {
    unsigned* bar; unsigned x;
    volatile LAS unsigned* st;
};

__device__ __forceinline__ XcdBarrier xcd_barrier_post(unsigned* bar, volatile LAS unsigned* st) {
    XcdBarrier b; b.bar = bar; b.x = xb_xcc_id(); b.st = st;
    if (threadIdx.x == 0) (void)xb_add(&bar[XB_XCNT(b.x)], 1u);
    return b;
}
__device__ __forceinline__ void xcd_barrier_complete(unsigned* bar, unsigned x, unsigned& nloc, unsigned& nx) {
    const unsigned G = gridDim.x * gridDim.y * gridDim.z;
    unsigned sum, cnt, mine, sp = 0u;
    for (;;) {
        sum = 0u; cnt = 0u; mine = 0u;
#pragma unroll
        for (unsigned j = 0; j < 16; ++j) { const unsigned c = xb_ld(&bar[XB_XCNT(j)]); sum += c; cnt += (c > 0u) ? 1u : 0u; mine = (j == x) ? c : mine; }
        if (sum == G) break;
        __builtin_amdgcn_s_sleep(1);
        if ((++sp & 255u) == 0u) { if (xb_ld(&bar[XB_TMO])) break; if (sp > XB_SPIN_CAP) { atomicAdd(&bar[XB_TMO], 1u); break; } }
    }
    nloc = mine > 0u ? mine : 1u; nx = cnt > 0u ? cnt : 1u;
}

__device__ __forceinline__ void xcd_barrier(const XcdBarrier& b) {
    asm volatile("s_waitcnt vmcnt(0)" ::: "memory");
    __syncthreads();
    if (threadIdx.x == 0) {
        unsigned* bar = b.bar;
        __builtin_amdgcn_s_waitcnt(0);
        unsigned nloc = b.st[0], nx = b.st[1];
        if (nloc == 0u) { xcd_barrier_complete(bar, b.x, nloc, nx); b.st[0] = nloc; b.st[1] = nx; }
        const unsigned old = xb_add(&bar[XB_XSUB(b.x)], 1u);
        const unsigned gen = old / nloc;
        if (old + 1u == (gen + 1u) * nloc) {
            __builtin_amdgcn_fence(__ATOMIC_RELEASE, "agent");
            asm volatile("s_waitcnt vmcnt(0)" ::: "memory");
            const unsigned og = xb_add(&bar[XB_TOP], 1u);
            const unsigned tg = og / nx;
            if (og + 1u == (tg + 1u) * nx) xb_add(&bar[XB_TOPGEN], 1u);
            else XB_SPIN(xb_ld(&bar[XB_TOPGEN]) == tg, bar);
            __builtin_amdgcn_fence(__ATOMIC_ACQUIRE, "agent");
            xb_add(&bar[XB_XGEN(b.x)], 1u);
            asm volatile("s_waitcnt vmcnt(0)" ::: "memory");
        } else {
            XB_SPIN(xb_ld(&bar[XB_XGEN(b.x)]) == gen, bar);
            __builtin_amdgcn_fence(__ATOMIC_ACQUIRE, "agent");
            asm volatile("s_waitcnt vmcnt(0)" ::: "memory");
        }
    }
    __syncthreads();
}


constexpr int NWAVES = 8;
#ifndef MK_N_LAUNCHES
#define MK_N_LAUNCHES 1
#endif
constexpr int PER_PHASE = 9;
constexpr int N_LAUNCHES = MK_N_LAUNCHES;

constexpr int BATCH = 4, SEQ = 8192, D = 1024, M = BATCH * SEQ, NP1 = 6656, NGATE = 2048, FF = 2816, FF2 = 5632, KCAT = 1536;
constexpr float NORM_EPS = 1e-6f;
constexpr int NHR = 3 * BATCH * 8 * SEQ;

constexpr size_t MiB = 1u << 20;
constexpr size_t WS_CTL = 0, CTL_ZERO_BYTES = 1 * MiB;
constexpr size_t WS_WIN = 2 * MiB;
constexpr size_t WS_WAB = 19 * MiB;
constexpr size_t WS_WOUT = 22 * MiB;
constexpr size_t WS_WGU = 24 * MiB;
constexpr size_t WS_WDN = 35 * MiB;
constexpr size_t WS_GWS = 41 * MiB;
constexpr size_t WS_SQ1 = 42 * MiB;
constexpr size_t WS_SQ2 = 44 * MiB;
constexpr size_t WS_LSE = 46 * MiB;
constexpr size_t WS_R = 50 * MiB;
constexpr size_t WS_U = WS_R, WS_VG = WS_R + 64 * MiB, WS_Q = WS_R + 128 * MiB, WS_K = WS_R + 224 * MiB, WS_V = WS_R + 320 * MiB;
constexpr size_t WS_YCAT = WS_K;
constexpr size_t WS_SG = WS_R;
constexpr size_t WS_MRG = WS_V;
constexpr size_t WS_H1B = WS_K;
constexpr size_t WS_ACT = WS_R;
constexpr size_t WS_END = WS_R + 416 * MiB;

constexpr int RING_OFF = 0, RING_BYTES = 131072;
constexpr int LDSCTL_OFF = RING_BYTES, MISC_OFF = LDSCTL_OFF + 320;
constexpr int LDS_BYTES = 147456;
constexpr int CW_BAR = 4096;

struct Args { const float* in[15]; float* out; unsigned char* ws; int ph_lo, ph_hi; };

struct Frame {
    LAS unsigned char* lds;
    volatile LAS unsigned* MISC;
    gu32* ctl;
    int tid, lane, wave, vcu, G;
};

__device__ __forceinline__ float wave_sum(float v) {
#pragma unroll
    for (int o = 1; o < 64; o <<= 1) v += __shfl_xor(v, o);
    return v;
}
__device__ __forceinline__ float wave_max(float v) {
#pragma unroll
    for (int o = 1; o < 64; o <<= 1) v = fmaxf(v, __shfl_xor(v, o));
    return v;
}
__device__ __forceinline__ float bf2f(unsigned short h) { return __uint_as_float((unsigned)h << 16); }

__device__ __forceinline__ void p0_transpose_item(const float* W, int K, int N, int ncol0, bf16* WT, int ldk, int k_off, int mode, int row_off, const float* kscale, LAS float* scr, int item, int nblk, int lane) {
    const int kb = item / nblk, nb = item % nblk, k0 = 64 * kb, n0 = 32 * nb;
#pragma unroll 8
    for (int i = 0; i < 32; ++i) { const int kk = 2 * i + (lane >> 5); float v = W[(size_t)(k0 + kk) * N + ncol0 + n0 + (lane & 31)]; if (kscale) v *= kscale[k0 + kk]; scr[kk * 33 + (lane & 31)] = v; }
    LDS_WAIT(); asm volatile("" ::: "memory");
    const int c = lane & 7; const int drow0 = mode == 0 ? row_off + n0 : ((n0 >> 7) << 8) + (n0 & 127) + row_off;
#pragma unroll
    for (int j = 0; j < 4; ++j) { const int n = (lane >> 3) + 8 * j; const LAS float* s = scr + (8 * c) * 33 + n;
        v4u o; o.x = pk2(s[0 * 33], s[1 * 33]); o.y = pk2(s[2 * 33], s[3 * 33]); o.z = pk2(s[4 * 33], s[5 * 33]); o.w = pk2(s[6 * 33], s[7 * 33]);
        *(GAS v4u*)(WT + (size_t)(drow0 + n) * ldk + k_off + k0 + 8 * c) = o; }
    LDS_WAIT(); asm volatile("" ::: "memory");
}
__device__ __forceinline__ void p0_prologue(Frame& F, const Args& a) {
    unsigned char* ws = a.ws;
    LAS float* scr = (LAS float*)(F.lds + RING_OFF + F.wave * 16384);
    const int gw = F.vcu * NWAVES + F.wave, NGW = F.G * NWAVES;
    constexpr int I_P1 = 16 * (NP1 / 32), I_G = 16 * (1024 / 32), I_A = 16 * 32, I_B = 8 * 32, I_O = 16 * 32, I_F = 16 * (FF / 32), I_D = (FF / 64) * 32;
    constexpr int NITEMS = I_P1 + 2 * I_G + I_A + I_B + I_O + 2 * I_F + I_D;
    const float* w_in = a.in[2];
    for (int it = gw; it < NITEMS; it += NGW) {
        int r = it;
        if (r < I_P1) { p0_transpose_item(w_in, D, 8704, 0, (bf16*)(ws + WS_WIN), D, 0, 0, 0, nullptr, scr, r, NP1 / 32, F.lane); continue; } r -= I_P1;
        if (r < I_G) { p0_transpose_item(w_in, D, 8704, 6656, (bf16*)(ws + WS_WIN), D, 0, 1, 6656, nullptr, scr, r, 32, F.lane); continue; } r -= I_G;
        if (r < I_G) { p0_transpose_item(w_in, D, 8704, 7680, (bf16*)(ws + WS_WIN), D, 0, 1, 6656 + 128, nullptr, scr, r, 32, F.lane); continue; } r -= I_G;
        if (r < I_A) { p0_transpose_item(a.in[7], 1024, 1024, 0, (bf16*)(ws + WS_WAB), KCAT, 0, 0, 0, nullptr, scr, r, 32, F.lane); continue; } r -= I_A;
        if (r < I_B) { p0_transpose_item(a.in[8], 512, 1024, 0, (bf16*)(ws + WS_WAB), KCAT, 1024, 0, 0, nullptr, scr, r, 32, F.lane); continue; } r -= I_B;
        if (r < I_O) { p0_transpose_item(a.in[9], 1024, 1024, 0, (bf16*)(ws + WS_WOUT), D, 0, 0, 0, nullptr, scr, r, 32, F.lane); continue; } r -= I_O;
        if (r < I_F) { p0_transpose_item(a.in[11], D, FF, 0, (bf16*)(ws + WS_WGU), D, 0, 1, 0, a.in[10], scr, r, FF / 32, F.lane); continue; } r -= I_F;
        if (r < I_F) { p0_transpose_item(a.in[12], D, FF, 0, (bf16*)(ws + WS_WGU), D, 0, 1, 128, a.in[10], scr, r, FF / 32, F.lane); continue; } r -= I_F;
        p0_transpose_item(a.in[13], FF, D, 0, (bf16*)(ws + WS_WDN), FF, 0, 0, 0, nullptr, scr, r, 32, F.lane);
    }
    { const float* gws = a.in[5]; bf16* o = (bf16*)(ws + WS_GWS); const int gt = F.vcu * (NWAVES * 64) + F.tid, NT = F.G * NWAVES * 64;
      for (int i = gt; i < 8 * 128 * 128 / 2; i += NT) ((GAS unsigned*)o)[i] = pk2(gws[2 * i], gws[2 * i + 1]); }
    { const float* x = a.in[0]; const float* g = a.in[1]; bf16* XN = (bf16*)a.out;
      f32x4 gv[4];
#pragma unroll
      for (int j = 0; j < 4; ++j) gv[j] = *((const GAS f32x4*)g + F.lane + 64 * j);
      for (int m = gw; m < M; m += NGW) {
        const GAS f32x4* xr = (const GAS f32x4*)(x + (size_t)m * D) + F.lane; f32x4 v[4]; float s = 0.f;
#pragma unroll
        for (int j = 0; j < 4; ++j) { v[j] = xr[64 * j]; s += (v[j].x * v[j].x + v[j].y * v[j].y) + (v[j].z * v[j].z + v[j].w * v[j].w); }
        const float rstd = 1.f / sqrtf(wave_sum(s) * (1.f / D) + NORM_EPS);
        GAS unsigned long long* o8 = (GAS unsigned long long*)(XN + (size_t)m * D) + F.lane;
#pragma unroll
        for (int j = 0; j < 4; ++j) o8[64 * j] = (unsigned long long)pk2(v[j].x * rstd * gv[j].x, v[j].y * rstd * gv[j].y) | ((unsigned long long)pk2(v[j].z * rstd * gv[j].z, v[j].w * rstd * gv[j].w) << 32);
      } }
}

__device__ __forceinline__ void attn_simple(Frame& F, bf16* Qb, const bf16* Kb, const bf16* Vb, float* LSE) {
    const int gw = F.vcu * NWAVES + F.wave, NGW = F.G * NWAVES, lane = F.lane;
    for (int R = gw; R < NHR; R += NGW) {
        const int g = R >> 18, rem = R & 262143, b = rem >> 16, h = (rem >> 13) & 7, p = rem & 8191;
        const int dlog = 2 * g, L = 8192 >> dlog, l = p & (L - 1), r = p >> (13 - dlog);
        const int seq0 = R - l;
        const float slope2 = __builtin_amdgcn_exp2f(-(float)(g * 8 + h + 1) * (1.0f / 3.0f)) * (float)(1 << dlog) * 1.4426950408889634f;
        float q[64];
        { const GAS v4u* qp = (const GAS v4u*)(Qb + (size_t)R * 64);
#pragma unroll
          for (int c = 0; c < 8; ++c) { const v4u w = qp[c];
            q[8 * c + 0] = __uint_as_float(w.x << 16); q[8 * c + 1] = __uint_as_float(w.x & 0xffff0000u); q[8 * c + 2] = __uint_as_float(w.y << 16); q[8 * c + 3] = __uint_as_float(w.y & 0xffff0000u);
            q[8 * c + 4] = __uint_as_float(w.z << 16); q[8 * c + 5] = __uint_as_float(w.z & 0xffff0000u); q[8 * c + 6] = __uint_as_float(w.w << 16); q[8 * c + 7] = __uint_as_float(w.w & 0xffff0000u); } }
        float s[3]; bool ok[3];
#pragma unroll
        for (int ps = 0; ps < 3; ++ps) {
            const int j = lane + 64 * ps - 64, kl = l + j; ok[ps] = (j <= 64) && (kl >= 0) && (kl < L);
            const int klc = kl < 0 ? 0 : (kl > L - 1 ? L - 1 : kl);
            const GAS v4u* kp = (const GAS v4u*)(Kb + (size_t)(seq0 + klc) * 64); float acc = 0.f;
#pragma unroll
            for (int c = 0; c < 8; ++c) { const v4u w = kp[c];
                acc += q[8 * c + 0] * __uint_as_float(w.x << 16) + q[8 * c + 1] * __uint_as_float(w.x & 0xffff0000u) + q[8 * c + 2] * __uint_as_float(w.y << 16) + q[8 * c + 3] * __uint_as_float(w.y & 0xffff0000u)
                     + q[8 * c + 4] * __uint_as_float(w.z << 16) + q[8 * c + 5] * __uint_as_float(w.z & 0xffff0000u) + q[8 * c + 6] * __uint_as_float(w.w << 16) + q[8 * c + 7] * __uint_as_float(w.w & 0xffff0000u); }
            const float aj = (float)(j < 0 ? -j : j);
            s[ps] = ok[ps] ? acc - slope2 * aj : -1e30f;
        }
        const float mx = wave_max(fmaxf(fmaxf(s[0], s[1]), s[2]));
        float pr[3]; float ls = 0.f;
#pragma unroll
        for (int ps = 0; ps < 3; ++ps) { pr[ps] = ok[ps] ? __builtin_amdgcn_exp2f(s[ps] - mx) : 0.f; ls += pr[ps]; }
        ls = wave_sum(ls);
        float o = 0.f;
#pragma unroll
        for (int ps = 0; ps < 3; ++ps) {
            const int nj = ps == 2 ? 1 : 64;
            for (int jj = 0; jj < nj; ++jj) {
                const float pj = __uint_as_float((unsigned)__builtin_amdgcn_readlane((int)__float_as_uint(pr[ps]), jj));
                int kl = l + jj + 64 * ps - 64; kl = kl < 0 ? 0 : (kl > L - 1 ? L - 1 : kl);
                o += pj * bf2f(Vb[(size_t)(seq0 + kl) * 64 + lane]);
            }
        }
        o = o / ls;
        Qb[(size_t)R * 64 + lane] = (bf16)f2bf(o);
        if (lane == 0) { const int token = b * SEQ + (l << dlog) + r; LSE[((size_t)g * M + token) * 8 + h] = mx + __builtin_amdgcn_logf(ls); }
    }
}

namespace att {
typedef short bf16x8 __attribute__((ext_vector_type(8)));
typedef short s16x4 __attribute__((ext_vector_type(4)));
typedef float f32x16 __attribute__((ext_vector_type(16)));
typedef unsigned u32x2 __attribute__((ext_vector_type(2)));
typedef __attribute__((address_space(3))) const unsigned char* lds_cptr;
constexpr int IMG_ROWS = 384, LDS_K = 0, LDS_V = IMG_ROWS * 128;
__device__ __forceinline__ int sw(int row) { return (((row >> 1) & 1) << 2) | (((row >> 2) & 1) << 1) | ((row >> 3) & 1); }
__device__ __forceinline__ void glds16(const void* gsrc, unsigned lds_dst) { unsigned keep;
    asm volatile("s_mov_b32 %0, m0\n\ts_mov_b32 m0, %2\n\ts_nop 0\n\tglobal_load_lds_dwordx4 %1, off\n\ts_mov_b32 m0, %0" : "=&s"(keep) : "v"(gsrc), "s"(lds_dst) : "memory"); }
__device__ __forceinline__ s16x4 vtr(lds_cptr p) { typedef short v4i16_t __attribute__((ext_vector_type(4))); return __builtin_bit_cast(s16x4, __builtin_amdgcn_ds_read_tr16_b64_v4i16((__attribute__((address_space(3))) v4i16_t*)p)); }
__device__ __forceinline__ unsigned cvtpk(float lo, float hi) { typedef float f2 __attribute__((ext_vector_type(2))); typedef __bf16 b2 __attribute__((ext_vector_type(2))); f2 v = {lo, hi}; b2 b = __builtin_convertvector(v, b2); return __builtin_bit_cast(unsigned, b); }

__device__ __forceinline__ void attn_phase(LAS unsigned char* lds, int vcu, int G, unsigned short* Qb, const unsigned short* Kb, const unsigned short* Vb, float* LSE) {
    int tid_ = threadIdx.x; asm volatile("" : "+v"(tid_));
    const int lane = tid_ & 63, w = __builtin_amdgcn_readfirstlane(tid_ >> 6), ql = lane & 31, hi = lane >> 5;
    const unsigned lds0 = (unsigned)(uintptr_t)lds;
    const lds_cptr L3 = (lds_cptr)lds;
    const int swl = sw(ql);
    int koff[4];
#pragma unroll
    for (int d0 = 0; d0 < 4; ++d0) koff[d0] = LDS_K + (32 * w + ql) * 128 + (((2 * d0 + hi) ^ swl) << 4);
    const int p_ = lane & 3, qrow = (lane & 15) >> 2, gi = (lane >> 4) & 1;
    const int sw0 = ((qrow >> 1) << 2) | (hi << 1);
    int voff[2][2];
#pragma unroll
    for (int dh = 0; dh < 2; ++dh)
#pragma unroll
        for (int sec = 0; sec < 2; ++sec) voff[dh][sec] = LDS_V + (32 * w + 4 * hi + qrow + 8 * sec) * 128 + (((4 * dh + 2 * gi + (p_ >> 1)) ^ (sw0 | sec)) << 4) + (p_ & 1) * 8;
    const float fbase = (float)(4 * hi - ql - 64);
    constexpr int NUNITS = 3 * 4 * 8 * 8192 / 256;
    for (int U = vcu; U < NUNITS; U += G) {
        const int R0 = U * 256, g = R0 >> 18, rem = R0 & 262143, b = rem >> 16, h = (rem >> 13) & 7, p0 = rem & 8191;
        const int dlog = 2 * g, L = 8192 >> dlog, l0 = p0 & (L - 1), r = p0 >> (13 - dlog), seq0 = R0 - l0;
        const float slope2 = __builtin_amdgcn_exp2f(-(float)(g * 8 + h + 1) * (1.0f / 3.0f)) * (float)(1 << dlog) * 1.4426950408889634f;
        __syncthreads();
#pragma unroll
        for (int i = 0; i < 6; ++i) { const int pc = w * 6 + i, row = 8 * pc + (lane >> 3); int ls = l0 - 64 + row; ls = ls < 0 ? 0 : (ls > L - 1 ? L - 1 : ls);
            const size_t eo = (size_t)(seq0 + ls) * 64 + (size_t)(((lane & 7) ^ sw(row)) << 3);
            glds16(Kb + eo, (unsigned)__builtin_amdgcn_readfirstlane(lds0 + LDS_K + pc * 1024));
            glds16(Vb + eo, (unsigned)__builtin_amdgcn_readfirstlane(lds0 + LDS_V + pc * 1024)); }
        bf16x8 qr[4];
        { const unsigned short* qp = Qb + (size_t)(R0 + 32 * w + ql) * 64 + 8 * hi;
#pragma unroll
          for (int d0 = 0; d0 < 4; ++d0) qr[d0] = *(const bf16x8*)(qp + 16 * d0); }
        asm volatile("s_waitcnt vmcnt(0)" ::: "memory");
        __syncthreads();
        f32x16 p[5];
#pragma unroll
        for (int t = 0; t < 5; ++t) {
            p[t] = (f32x16){0.f, 0.f, 0.f, 0.f, 0.f, 0.f, 0.f, 0.f, 0.f, 0.f, 0.f, 0.f, 0.f, 0.f, 0.f, 0.f};
#pragma unroll
            for (int d0 = 0; d0 < 4; ++d0) { const bf16x8 kf = *(const __attribute__((address_space(3))) bf16x8*)(L3 + koff[d0] + t * 4096); p[t] = __builtin_amdgcn_mfma_f32_32x32x16_bf16(kf, qr[d0], p[t], 0, 0, 0); }
        }
        const int kv0 = l0 + 32 * w - 64;
        float mx = -INFINITY;
#pragma unroll
        for (int t = 0; t < 5; ++t) {
            const bool tv = (kv0 + 32 * t >= 0) && (kv0 + 32 * t + 31 < L);
#pragma unroll
            for (int r16 = 0; r16 < 16; ++r16) { const float fd = fbase + (float)(32 * t + (r16 & 3) + 8 * (r16 >> 2));
                float s = __builtin_fmaf(-slope2, __builtin_fabsf(fd), p[t][r16]);
                if (t == 0) s = (fd >= -64.0f) ? s : -INFINITY;
                if (t == 4) s = (fd <= 64.0f) ? s : -INFINITY;
                s = tv ? s : -INFINITY;
                p[t][r16] = s; mx = fmaxf(mx, s); }
        }
        mx = fmaxf(mx, __shfl_xor(mx, 32));
        float lsum = 0.f;
#pragma unroll
        for (int t = 0; t < 5; ++t)
#pragma unroll
            for (int r16 = 0; r16 < 16; ++r16) { const float e = __builtin_amdgcn_exp2f(p[t][r16] - mx); p[t][r16] = e; lsum += e; }
        lsum += __shfl_xor(lsum, 32);
        f32x16 o[2];
        o[0] = (f32x16){0.f, 0.f, 0.f, 0.f, 0.f, 0.f, 0.f, 0.f, 0.f, 0.f, 0.f, 0.f, 0.f, 0.f, 0.f, 0.f}; o[1] = o[0];
#pragma unroll
        for (int t = 0; t < 5; ++t)
#pragma unroll
            for (int s2 = 0; s2 < 2; ++s2) {
                typedef unsigned u32x4 __attribute__((ext_vector_type(4)));
                u32x4 pw; pw.x = cvtpk(p[t][8 * s2 + 0], p[t][8 * s2 + 1]); pw.y = cvtpk(p[t][8 * s2 + 2], p[t][8 * s2 + 3]); pw.z = cvtpk(p[t][8 * s2 + 4], p[t][8 * s2 + 5]); pw.w = cvtpk(p[t][8 * s2 + 6], p[t][8 * s2 + 7]);
                const bf16x8 pf = __builtin_bit_cast(bf16x8, pw);
#pragma unroll
                for (int dh = 0; dh < 2; ++dh) { const s16x4 a = vtr(L3 + voff[dh][0] + t * 4096 + s2 * 2048), c = vtr(L3 + voff[dh][1] + t * 4096 + s2 * 2048);
                    const bf16x8 vf = (bf16x8){a[0], a[1], a[2], a[3], c[0], c[1], c[2], c[3]};
                    o[dh] = __builtin_amdgcn_mfma_f32_32x32x16_bf16(vf, pf, o[dh], 0, 0, 0); }
            }
        const float rl = 1.0f / lsum;
        unsigned short* op = Qb + (size_t)(R0 + 32 * w + ql) * 64 + 4 * hi;
#pragma unroll
        for (int dh = 0; dh < 2; ++dh)
#pragma unroll
            for (int k4 = 0; k4 < 4; ++k4) { u32x2 v; v.x = cvtpk(o[dh][4 * k4 + 0] * rl, o[dh][4 * k4 + 1] * rl); v.y = cvtpk(o[dh][4 * k4 + 2] * rl, o[dh][4 * k4 + 3] * rl);
                *(u32x2*)(op + 32 * dh + 8 * k4) = v; }
        if (hi == 0) { const int l = l0 + 32 * w + ql, token = b * 8192 + (l << dlog) + r; LSE[((size_t)g * 32768 + token) * 8 + h] = mx + __builtin_amdgcn_logf(lsum); }
    }
    __syncthreads();
}
}

__device__ __forceinline__ void gmlp_merge_simple(Frame& F, const Args& a) {
    unsigned char* ws = a.ws;
    const bf16* U = (const bf16*)(ws + WS_U); const bf16* VG = (const bf16*)(ws + WS_VG); const bf16* Ob = (const bf16*)(ws + WS_Q); const float* LSE = (const float*)(ws + WS_LSE);
    const bf16* GWS = (const bf16*)(ws + WS_GWS); bf16* YC = (bf16*)(ws + WS_YCAT);
    const float* ln_g = a.in[3]; const float* ln_b = a.in[4]; const float* bs = a.in[6];
    LAS float* st = (LAS float*)(F.lds + RING_BYTES + 1024);
    LAS float* vn = (LAS float*)(F.lds);
    LAS float* wsl = (LAS float*)(F.lds + 65536);
    const int tid = F.tid, lane = F.lane, wave = F.wave;
    for (int ci = F.vcu; ci < M / 128; ci += F.G) {
        const int tok0 = ci * 128;
        for (int i = 0; i < 16; ++i) { const int tk = wave * 16 + i; const GAS v4u* rp = (const GAS v4u*)(VG + (size_t)(tok0 + tk) * 1024);
            float v[16];
#pragma unroll
            for (int j = 0; j < 2; ++j) { const v4u w = rp[lane + 64 * j];
                v[8 * j + 0] = __uint_as_float(w.x << 16); v[8 * j + 1] = __uint_as_float(w.x & 0xffff0000u); v[8 * j + 2] = __uint_as_float(w.y << 16); v[8 * j + 3] = __uint_as_float(w.y & 0xffff0000u);
                v[8 * j + 4] = __uint_as_float(w.z << 16); v[8 * j + 5] = __uint_as_float(w.z & 0xffff0000u); v[8 * j + 6] = __uint_as_float(w.w << 16); v[8 * j + 7] = __uint_as_float(w.w & 0xffff0000u); }
            float s = 0.f;
#pragma unroll
            for (int j = 0; j < 16; ++j) s += v[j];
            const float mean = wave_sum(s) * (1.0f / 1024.0f); float q = 0.f;
#pragma unroll
            for (int j = 0; j < 16; ++j) { const float d = v[j] - mean; q += d * d; }
            const float rstd = 1.0f / sqrtf(wave_sum(q) * (1.0f / 1024.0f) + NORM_EPS);
            if (lane == 0) { st[2 * tk] = mean; st[2 * tk + 1] = rstd; } }
        __syncthreads();
        for (int g = 0; g < 8; ++g) {
#pragma unroll
            for (int i = 0; i < 4; ++i) { const int idx = tid + 512 * i, s = idx >> 4, c8 = (idx & 15) * 8;
                const v4u w = *(const GAS v4u*)(VG + (size_t)(tok0 + s) * 1024 + 128 * g + c8); const float mean = st[2 * s], rstd = st[2 * s + 1];
                const float* lg = ln_g + 128 * g + c8; const float* lb = ln_b + 128 * g + c8; LAS float* d = vn + s * 128 + c8;
                d[0] = (__uint_as_float(w.x << 16) - mean) * rstd * lg[0] + lb[0]; d[1] = (__uint_as_float(w.x & 0xffff0000u) - mean) * rstd * lg[1] + lb[1];
                d[2] = (__uint_as_float(w.y << 16) - mean) * rstd * lg[2] + lb[2]; d[3] = (__uint_as_float(w.y & 0xffff0000u) - mean) * rstd * lg[3] + lb[3];
                d[4] = (__uint_as_float(w.z << 16) - mean) * rstd * lg[4] + lb[4]; d[5] = (__uint_as_float(w.z & 0xffff0000u) - mean) * rstd * lg[5] + lb[5];
                d[6] = (__uint_as_float(w.w << 16) - mean) * rstd * lg[6] + lb[6]; d[7] = (__uint_as_float(w.w & 0xffff0000u) - mean) * rstd * lg[7] + lb[7];
                const v4u x = *(const GAS v4u*)(GWS + (size_t)g * 16384 + (size_t)s * 128 + c8); LAS float* e = wsl + s * 128 + c8;
                e[0] = __uint_as_float(x.x << 16); e[1] = __uint_as_float(x.x & 0xffff0000u); e[2] = __uint_as_float(x.y << 16); e[3] = __uint_as_float(x.y & 0xffff0000u);
                e[4] = __uint_as_float(x.z << 16); e[5] = __uint_as_float(x.z & 0xffff0000u); e[6] = __uint_as_float(x.w << 16); e[7] = __uint_as_float(x.w & 0xffff0000u); }
            __syncthreads();
            const int c = tid & 127, tq = tid >> 7;
            float acc[32];
#pragma unroll
            for (int tt = 0; tt < 32; ++tt) acc[tt] = 0.f;
            for (int s = 0; s < 128; s += 4) {
                const float v0 = vn[(s + 0) * 128 + c], v1 = vn[(s + 1) * 128 + c], v2 = vn[(s + 2) * 128 + c], v3 = vn[(s + 3) * 128 + c];
#pragma unroll
                for (int tt = 0; tt < 32; ++tt) { const f32x4 w4 = *(const LAS f32x4*)(wsl + (32 * tq + tt) * 128 + s); acc[tt] += w4.x * v0 + w4.y * v1 + w4.z * v2 + w4.w * v3; }
            }
#pragma unroll
            for (int tt = 0; tt < 32; ++tt) { const int t = 32 * tq + tt; const size_t tok = (size_t)(tok0 + t);
                const float uu = bf2f(U[tok * 1024 + 128 * g + c]); YC[tok * KCAT + 128 * g + c] = (bf16)f2bf(uu * (acc[tt] + bs[g * 128 + t])); }
            __syncthreads();
        }
        for (int i = 0; i < 128; ++i) { const int idx = tid + 512 * i, tk = idx >> 9, ch = idx & 511, h = ch >> 6, dd = ch & 63; const int token = tok0 + tk, b = token >> 13, t = token & 8191;
            float ls[3], ov[3];
#pragma unroll
            for (int g = 0; g < 3; ++g) { const int dlog = 2 * g, r = t & ((1 << dlog) - 1), l = t >> dlog; const size_t hr = (size_t)(((g * 4 + b) * 8 + h) * 8192 + r * (8192 >> dlog) + l);
                ov[g] = bf2f(Ob[hr * 64 + dd]); ls[g] = LSE[((size_t)g * M + token) * 8 + h]; }
            const float mx = fmaxf(fmaxf(ls[0], ls[1]), ls[2]); const float w0 = __builtin_amdgcn_exp2f(ls[0] - mx), w1 = __builtin_amdgcn_exp2f(ls[1] - mx), w2 = __builtin_amdgcn_exp2f(ls[2] - mx);
            YC[(size_t)token * KCAT + 1024 + ch] = (bf16)f2bf((w0 * ov[0] + w1 * ov[1] + w2 * ov[2]) / (w0 + w1 + w2)); }
        __syncthreads();
    }
}

__device__ __forceinline__ void final_norm(Frame& F, const Args& a) {
    const float* SQ = (const float*)(a.ws + WS_SQ2); const float* g = a.in[14]; float* out = a.out;
    const int gw = F.vcu * NWAVES + F.wave, NGW = F.G * NWAVES;
    f32x4 gv[4];
#pragma unroll
    for (int j = 0; j < 4; ++j) gv[j] = *((const GAS f32x4*)g + F.lane + 64 * j);
    for (int m = gw; m < M; m += NGW) {
        float s = F.lane < 16 ? SQ[(size_t)m * 16 + F.lane] : 0.f; s = wave_sum(s);
        const float rstd = 1.f / sqrtf(s * (1.f / D) + NORM_EPS);
        GAS f32x4* xr = (GAS f32x4*)(out + (size_t)m * D) + F.lane;
#pragma unroll
        for (int j = 0; j < 4; ++j) { const f32x4 v = xr[64 * j]; xr[64 * j] = v * rstd * gv[j]; }
    }
}

__global__ void __launch_bounds__(NWAVES * 64, 2) mk_fwd(Args args) {
    extern __shared__ __attribute__((aligned(16))) unsigned char lds[];
    Frame F;
    F.lds = (LAS unsigned char*)lds;
    F.MISC = (volatile LAS unsigned*)(F.lds + MISC_OFF);
#define REFRAME() do { int t_ = threadIdx.x; asm volatile("" : "+v"(t_)); F.tid = t_; F.lane = t_ & 63; F.wave = __builtin_amdgcn_readfirstlane(t_ >> 6); } while (0)
    REFRAME();
    F.G = gridDim.x; { const int bx = blockIdx.x; F.vcu = (F.G % 8 == 0) ? (bx % 8) * (F.G / 8) + bx / 8 : bx; }
    unsigned char* ws = args.ws;
    F.ctl = (gu32*)(ws + WS_CTL);
    for (int u = F.tid; u < (LDS_BYTES - LDSCTL_OFF) / 4; u += NWAVES * 64) ((LAS unsigned*)(F.lds + LDSCTL_OFF))[u] = 0u;
    __syncthreads();
    XcdBarrier bar; bar.bar = (unsigned*)(F.ctl + CW_BAR); bar.x = 0; bar.st = nullptr;
    if (N_LAUNCHES != PER_PHASE) bar = xcd_barrier_post((unsigned*)(F.ctl + CW_BAR), F.MISC + 8);
#define GRID_BAR() do { if (N_LAUNCHES != PER_PHASE) xcd_barrier(bar); } while (0)
    const int lo = args.ph_lo, hi = args.ph_hi;
#define IN(k) (lo <= (k) && (k) < hi)
#define BOTH(k) (IN(k) && IN((k) + 1))
    bf16* XN = (bf16*)args.out;
    bf16* WIN = (bf16*)(ws + WS_WIN);

    if (IN(0)) { p0_prologue(F, args); if (BOTH(0)) GRID_BAR(); }

    if (IN(1)) {
        pg8::Gemm g{XN, WIN, M, NP1, D}; pg8::StaticOrder S; S.init(M, NP1, F.G, (int)blockIdx.x);
        pg8::EpiProj E{(bf16*)(ws + WS_R)};
        pg8::gemm_phase<pg8::EpiProj, pg8::StaticOrder, true, true>(F.lds + RING_OFF, g, S, E);
        if (BOTH(1)) GRID_BAR();
    }
    if (IN(2)) { att::attn_phase(F.lds + RING_OFF, F.vcu, F.G, (bf16*)(ws + WS_Q), (const bf16*)(ws + WS_K), (const bf16*)(ws + WS_V), (float*)(ws + WS_LSE)); if (BOTH(2)) GRID_BAR(); }
    if (IN(3)) { REFRAME(); gmlp_merge_simple(F, args); if (BOTH(3)) GRID_BAR(); }
    if (IN(4)) {
        { pg8::Gemm g{XN, WIN + (size_t)NP1 * D, M, NGATE, D}; pg8::GateOrder S; S.init(M, F.G, (int)blockIdx.x);
          pg8::EpiGate E{(bf16*)(ws + WS_SG)};
          pg8::gemm_phase<pg8::EpiGate, pg8::GateOrder, true, true>(F.lds + RING_OFF, g, S, E); }
        { pg8::Gemm g{(const bf16*)(ws + WS_YCAT), (const bf16*)(ws + WS_WAB), M, D, KCAT}; pg8::StaticOrder S; S.init(M, D, F.G, (int)blockIdx.x);
          pg8::EpiMerge E{(const bf16*)(ws + WS_SG), (bf16*)(ws + WS_MRG)};
          pg8::gemm_phase<pg8::EpiMerge, pg8::StaticOrder, true, true>(F.lds + RING_OFF, g, S, E); }
        if (BOTH(4)) GRID_BAR();
    }
    if (IN(5)) {
        pg8::Gemm g{(const bf16*)(ws + WS_MRG), (const bf16*)(ws + WS_WOUT), M, D, D}; pg8::StaticOrder S; S.init(M, D, F.G, (int)blockIdx.x);
        pg8::EpiRes E{args.in[0], args.out, (bf16*)(ws + WS_H1B), (float*)(ws + WS_SQ1)};
        pg8::gemm_phase<pg8::EpiRes, pg8::StaticOrder, true, true>(F.lds + RING_OFF, g, S, E);
        if (BOTH(5)) GRID_BAR();
    }
    if (IN(6)) {
        pg8::Gemm g{(const bf16*)(ws + WS_H1B), (const bf16*)(ws + WS_WGU), M, FF2, D}; pg8::StaticOrder S; S.init(M, FF2, F.G, (int)blockIdx.x);
        pg8::EpiSwiglu E{(const float*)(ws + WS_SQ1), (bf16*)(ws + WS_ACT), NORM_EPS};
        pg8::gemm_phase<pg8::EpiSwiglu, pg8::StaticOrder, true, true>(F.lds + RING_OFF, g, S, E);
        if (BOTH(6)) GRID_BAR();
    }
    if (IN(7)) {
        pg8::Gemm g{(const bf16*)(ws + WS_ACT), (const bf16*)(ws + WS_WDN), M, D, FF}; pg8::StaticOrder S; S.init(M, D, F.G, (int)blockIdx.x);
        pg8::EpiRes E{args.out, args.out, nullptr, (float*)(ws + WS_SQ2)};
        pg8::gemm_phase<pg8::EpiRes, pg8::StaticOrder, true, true>(F.lds + RING_OFF, g, S, E);
        if (BOTH(7)) GRID_BAR();
    }
    if (IN(8)) { REFRAME(); final_norm(F, args); }
#undef IN
#undef BOTH
}

extern "C" void kernel_launch(void* const* d_in, const int* in_sizes, int n_in, void* d_out, int out_size, void* d_ws, size_t ws_size, hipStream_t stream) {
    static int grid = 0;
    if (grid == 0) {
        if (n_in != 15 || out_size != M * D || ws_size < WS_END) { fprintf(stderr, "kernel_launch: unexpected shapes: n_in %d out %d ws %zu (need >= %zu)\n", n_in, out_size, ws_size, (size_t)WS_END); grid = -1; return; }
        int dev = 0, cus = 0, per_cu = 0;
        if (hipGetDevice(&dev) != hipSuccess || hipDeviceGetAttribute(&cus, hipDeviceAttributeMultiprocessorCount, dev) != hipSuccess) { grid = -1; return; }
        if (hipFuncSetAttribute((const void*)mk_fwd, hipFuncAttributeMaxDynamicSharedMemorySize, LDS_BYTES) != hipSuccess) { fprintf(stderr, "kernel_launch: hipFuncSetAttribute failed\n"); grid = -1; return; }
        if (hipOccupancyMaxActiveBlocksPerMultiprocessor(&per_cu, (const void*)mk_fwd, NWAVES * 64, LDS_BYTES) != hipSuccess || per_cu < 1)
            fprintf(stderr, "kernel_launch: occupancy query reports %d workgroups per CU\n", per_cu);
        (void)hipGetLastError();
        grid = cus;
    }
    if (grid < 0) return;
    if (hipMemsetAsync((char*)d_ws + WS_CTL, 0, CTL_ZERO_BYTES, stream) != hipSuccess) { fprintf(stderr, "kernel_launch: hipMemsetAsync failed\n"); return; }
    Args a{};
    for (int i = 0; i < 15; ++i) a.in[i] = (const float*)d_in[i];
    a.out = (float*)d_out; a.ws = (unsigned char*)d_ws;
    for (int li = 0; li < N_LAUNCHES; ++li) {
        a.ph_lo = (N_LAUNCHES == PER_PHASE) ? li : 0; a.ph_hi = (N_LAUNCHES == PER_PHASE) ? li + 1 : PER_PHASE;
        hipLaunchKernelGGL(mk_fwd, dim3(grid), dim3(NWAVES * 64), LDS_BYTES, stream, a);
        const hipError_t le = hipPeekAtLastError();
        if (le != hipSuccess) { fprintf(stderr, "kernel_launch: launch %d failed: %s\n", li, hipGetErrorName(le)); break; }
    }
}
```

```cpp
#include <hip/hip_runtime.h>
#include <cstdio>
#include <cstdint>
namespace pg8 {
#define PG8_LAS __attribute__((address_space(3)))
typedef unsigned short bf16_t;
typedef short bf16x8 __attribute__((ext_vector_type(8)));
typedef float f32x4 __attribute__((ext_vector_type(4)));
typedef unsigned u32x4 __attribute__((ext_vector_type(4)));
constexpr int BM = 256, BK = 64, HALF = 128, HTB = HALF * BK * 2  , STAGE_BYTES = 8 * HTB, NXCD = 8, WGM = 8;

__host__ __device__ __forceinline__ int lds_byte(int r, int c) { const int st = (r >> 4) * 2 + (c >> 5), rr = r & 15, cc = c & 31, ob = rr * 64 + cc * 2; return st * 1024 + (ob ^ (((ob >> 9) & 1) << 5)); }
__host__ __device__ __forceinline__ void stage_rc(int b, int& R, int& C) { const int st = b / 1024, sb = b % 1024, swz = sb ^ (((sb >> 9) & 1) << 5); R = (st >> 1) * 16 + swz / 64; C = (st & 1) * 32 + (swz % 64) / 2; }
__host__ __device__ __forceinline__ int perm32(int rho) { const int n = rho >> 4, i = rho & 15; return 8 * (i >> 2) + 4 * n + (i & 3); }

struct Unit { int pm, pn; };
struct Gemm { const bf16_t* A; const bf16_t* Bt; int M, N, K; };

struct StaticOrder {
    int nM, nN, nwg, G, c;
    __host__ __device__ void init(int M, int N, int G_, int c_) { nM = M / BM; nN = N / BM; nwg = nM * nN; G = G_; c = c_; }
    __host__ __device__ bool next(int i, Unit& u) const {
        const long L = (long)i * G + c; if (L >= nwg) return false;
        int wgid = (int)L; { const int q = nwg / NXCD, r = nwg % NXCD, xcd = wgid % NXCD, off = wgid / NXCD; wgid = (xcd < r ? xcd * (q + 1) : r * (q + 1) + (xcd - r) * q) + off; }
        const int nig = WGM * nN, gid = wgid / nig, fm = gid * WGM, gsz = (nM - fm) < WGM ? (nM - fm) : WGM;
        u.pm = fm + ((wgid % nig) % gsz); u.pn = (wgid % nig) / gsz; return true;
    }
    __device__ __forceinline__ void a_ready(const Unit&) const {}
    __device__ __forceinline__ void done(const Unit&) const {}
};

__device__ __forceinline__ unsigned cvt_pk_bf16(float lo, float hi) { unsigned r; asm volatile("v_cvt_pk_bf16_f32 %0, %1, %2" : "=v"(r) : "v"(lo), "v"(hi)); return r; }
typedef float f32x2 __attribute__((ext_vector_type(2)));
__device__ __forceinline__ f32x2 gelu_pk(f32x2 v) {
    const f32x2 av = __builtin_elementwise_abs(v), d = av * 0.2316418882f + 1.0f;
    f32x2 t; t.x = __builtin_amdgcn_rcpf(d.x); t.y = __builtin_amdgcn_rcpf(d.y);
    f32x2 q = t * 0.5307027145f + (-0.7265760135f); q = q * t + 0.7107068705f; q = q * t + (-0.142248368f); q = q * t + 0.127414796f; q = q * t;
    const f32x2 s = (v * v) * (-0.72134752044f);
    f32x2 e; e.x = __builtin_amdgcn_exp2f(s.x); e.y = __builtin_amdgcn_exp2f(s.y);
    const f32x2 m = v * (q * e), r = v - m;
    f32x2 o; o.x = v.x < 0.f ? m.x : r.x; o.y = v.y < 0.f ? m.y : r.y; return o;
}


__device__ __forceinline__ float sigmoid_f(float x) { return __builtin_amdgcn_rcpf(1.0f + __builtin_amdgcn_exp2f(-1.4426950408889634f * x)); }
__device__ __forceinline__ float bf_lo(unsigned w) { return __uint_as_float(w << 16); }
__device__ __forceinline__ float bf_hi(unsigned w) { return __uint_as_float(w & 0xffff0000u); }
constexpr float QK_C2 = 0.125f * 1.4426950408889634f;

struct EpiProj {
    static constexpr bool PERM = true, AFTER_DRAIN = false; static constexpr int HOOK_T = -1;
    bf16_t* RB;
    __device__ __forceinline__ void hook(f32x4 (&)[2][2][4][2], const Unit&, int, int, int, int) const {}
    __device__ __forceinline__ void operator()(const f32x4 (&acc)[2][2][4][2], const Unit& u, int wr, int wc, int fr, int fq) const {
        asm volatile("" : "+v"(fr), "+v"(fq));
        const int pn = u.pn, row0 = u.pm * BM + wr * 64 + fr;
        if (pn < 8) {
            bf16_t* base = RB + (size_t)(pn >> 2) * (32u << 20); const int col0 = (pn & 3) * BM + wc * 32 + 8 * fq;
#pragma unroll
            for (int ai = 0; ai < 2; ++ai)
#pragma unroll
                for (int m = 0; m < 4; ++m) { bf16_t* rowp = base + (size_t)(row0 + ai * HALF + m * 16) * 1024 + col0;
#pragma unroll
                    for (int bj = 0; bj < 2; ++bj) { const f32x4 v0 = acc[ai][bj][m][0], v1 = acc[ai][bj][m][1];
                        const f32x2 a = gelu_pk((f32x2){v0[0], v0[1]}), b = gelu_pk((f32x2){v0[2], v0[3]}), c = gelu_pk((f32x2){v1[0], v1[1]}), d = gelu_pk((f32x2){v1[2], v1[3]});
                        u32x4 w; w.x = cvt_pk_bf16(a.x, a.y); w.y = cvt_pk_bf16(b.x, b.y); w.z = cvt_pk_bf16(c.x, c.y); w.w = cvt_pk_bf16(d.x, d.y);
                        *(u32x4*)(rowp + bj * HALF) = w; } }
        } else {
            const int t6 = pn - 8, which = t6 / 6, rem = t6 - which * 6, g = rem >> 1, half = rem & 1, dlog = 2 * g;
            bf16_t* base = RB + (size_t)(64u << 20) + (size_t)which * (48u << 20); const float sc = which == 0 ? QK_C2 : 1.0f;
#pragma unroll
            for (int bj = 0; bj < 2; ++bj) { const int cg = half * 256 + bj * HALF + wc * 32 + 8 * fq, h = cg >> 6, dd = cg & 63;
#pragma unroll
                for (int ai = 0; ai < 2; ++ai)
#pragma unroll
                    for (int m = 0; m < 4; ++m) { const int row = row0 + ai * HALF + m * 16, b = row >> 13, t = row & 8191, r = t & ((1 << dlog) - 1), l = t >> dlog;
                        const size_t hr = (size_t)(((g * 4 + b) * 8 + h) * 8192 + r * (8192 >> dlog) + l);
                        const f32x4 v0 = acc[ai][bj][m][0] * sc, v1 = acc[ai][bj][m][1] * sc;
                        u32x4 w; w.x = cvt_pk_bf16(v0[0], v0[1]); w.y = cvt_pk_bf16(v0[2], v0[3]); w.z = cvt_pk_bf16(v1[0], v1[1]); w.w = cvt_pk_bf16(v1[2], v1[3]);
                        *(u32x4*)(base + hr * 64 + dd) = w; } }
        }
    }
};

struct EpiGate {
    static constexpr bool PERM = true, AFTER_DRAIN = false; static constexpr int HOOK_T = -1;
    bf16_t* SG;
    __device__ __forceinline__ void hook(f32x4 (&)[2][2][4][2], const Unit&, int, int, int, int) const {}
    __device__ __forceinline__ void operator()(const f32x4 (&acc)[2][2][4][2], const Unit& u, int wr, int wc, int fr, int fq) const {
        asm volatile("" : "+v"(fr), "+v"(fq));
        const int row0 = u.pm * BM + wr * 64 + fr, j0 = u.pn * HALF + wc * 32 + 8 * fq;
#pragma unroll
        for (int ai = 0; ai < 2; ++ai)
#pragma unroll
            for (int m = 0; m < 4; ++m) { bf16_t* rowp = SG + (size_t)(row0 + ai * HALF + m * 16) * 2048 + j0;
                float rr[8], sb[8];
#pragma unroll
                for (int n = 0; n < 2; ++n)
#pragma unroll
                    for (int i = 0; i < 4; ++i) { const float ea = __builtin_amdgcn_exp2f(-1.4426950408889634f * acc[ai][0][m][n][i]), eb = __builtin_amdgcn_exp2f(-1.4426950408889634f * acc[ai][1][m][n][i]);
                        const float s = __builtin_amdgcn_rcpf(1.0f + eb); sb[n * 4 + i] = s; rr[n * 4 + i] = (1.0f + eb) * __builtin_amdgcn_rcpf(1.0f + ea); }
                u32x4 w; w.x = cvt_pk_bf16(rr[0], rr[1]); w.y = cvt_pk_bf16(rr[2], rr[3]); w.z = cvt_pk_bf16(rr[4], rr[5]); w.w = cvt_pk_bf16(rr[6], rr[7]);
                *(u32x4*)(rowp) = w;
                u32x4 x; x.x = cvt_pk_bf16(sb[0], sb[1]); x.y = cvt_pk_bf16(sb[2], sb[3]); x.z = cvt_pk_bf16(sb[4], sb[5]); x.w = cvt_pk_bf16(sb[6], sb[7]);
                *(u32x4*)(rowp + 1024) = x; }
    }
};

struct EpiMerge {
    static constexpr bool PERM = true, AFTER_DRAIN = false; static constexpr int HOOK_T = 16;
    const bf16_t* SG; bf16_t* O;
    __device__ __forceinline__ void hook(f32x4 (&acc)[2][2][4][2], const Unit& u, int wr, int wc, int fr, int fq) const {
        asm volatile("" : "+v"(fr), "+v"(fq));
        const int row0 = u.pm * BM + wr * 64 + fr, col0 = u.pn * BM + wc * 32 + 8 * fq;
#pragma unroll
        for (int ai = 0; ai < 2; ++ai)
#pragma unroll
            for (int m = 0; m < 4; ++m) { const bf16_t* rowp = SG + (size_t)(row0 + ai * HALF + m * 16) * 2048 + col0;
#pragma unroll
                for (int bj = 0; bj < 2; ++bj) { const u32x4 w = *(const u32x4*)(rowp + bj * HALF);
                    acc[ai][bj][m][0] = acc[ai][bj][m][0] * (f32x4){bf_lo(w.x), bf_hi(w.x), bf_lo(w.y), bf_hi(w.y)};
                    acc[ai][bj][m][1] = acc[ai][bj][m][1] * (f32x4){bf_lo(w.z), bf_hi(w.z), bf_lo(w.w), bf_hi(w.w)}; } }
    }
    __device__ __forceinline__ void operator()(const f32x4 (&acc)[2][2][4][2], const Unit& u, int wr, int wc, int fr, int fq) const {
        asm volatile("" : "+v"(fr), "+v"(fq));
        const int row0 = u.pm * BM + wr * 64 + fr, col0 = u.pn * BM + wc * 32 + 8 * fq;
#pragma unroll
        for (int ai = 0; ai < 2; ++ai)
#pragma unroll
            for (int m = 0; m < 4; ++m) { const size_t row = (size_t)(row0 + ai * HALF + m * 16);
#pragma unroll
                for (int bj = 0; bj < 2; ++bj) { const u32x4 w = *(const u32x4*)(SG + row * 2048 + 1024 + col0 + bj * HALF);
                    const f32x4 v0 = acc[ai][bj][m][0] * (f32x4){bf_lo(w.x), bf_hi(w.x), bf_lo(w.y), bf_hi(w.y)};
                    const f32x4 v1 = acc[ai][bj][m][1] * (f32x4){bf_lo(w.z), bf_hi(w.z), bf_lo(w.w), bf_hi(w.w)};
                    u32x4 o; o.x = cvt_pk_bf16(v0[0], v0[1]); o.y = cvt_pk_bf16(v0[2], v0[3]); o.z = cvt_pk_bf16(v1[0], v1[1]); o.w = cvt_pk_bf16(v1[2], v1[3]);
                    *(u32x4*)(O + row * 1024 + col0 + bj * HALF) = o; } }
    }
};

struct EpiRes {
    static constexpr bool PERM = false, AFTER_DRAIN = false; static constexpr int HOOK_T = -1;
    const float* base; float* out; bf16_t* outb; float* SQ;
    __device__ __forceinline__ void hook(f32x4 (&)[2][2][4][2], const Unit&, int, int, int, int) const {}
    __device__ __forceinline__ void operator()(const f32x4 (&acc)[2][2][4][2], const Unit& u, int wr, int wc, int fr, int fq) const {
        typedef unsigned u32x2v __attribute__((ext_vector_type(2)));
        asm volatile("" : "+v"(fr), "+v"(fq));
        const int row0 = u.pm * BM + wr * 64 + fr, col0 = u.pn * BM + wc * 32 + 4 * fq;
#pragma unroll
        for (int ai = 0; ai < 2; ++ai)
#pragma unroll
            for (int m = 0; m < 4; ++m) { const int row = row0 + ai * HALF + m * 16; const size_t off = (size_t)row * 1024 + col0; float ss = 0.f;
#pragma unroll
                for (int bj = 0; bj < 2; ++bj)
#pragma unroll
                    for (int n = 0; n < 2; ++n) { const size_t o2 = off + bj * HALF + n * 16; const f32x4 h = *(const f32x4*)(base + o2) + acc[ai][bj][m][n];
                        *(f32x4*)(out + o2) = h; ss += (h[0] * h[0] + h[1] * h[1]) + (h[2] * h[2] + h[3] * h[3]);
                        if (outb) { u32x2v w; w.x = cvt_pk_bf16(h[0], h[1]); w.y = cvt_pk_bf16(h[2], h[3]); *(u32x2v*)(outb + o2) = w; } }
                ss += __shfl_xor(ss, 16); ss += __shfl_xor(ss, 32);
                if (fq == 0) SQ[(size_t)row * 16 + u.pn * 4 + wc] = ss; }
    }
};

struct EpiSwiglu {
    static constexpr bool PERM = true, AFTER_DRAIN = false; static constexpr int HOOK_T = -1;
    const float* SQ; bf16_t* ACT; float eps;
    __device__ __forceinline__ void hook(f32x4 (&)[2][2][4][2], const Unit&, int, int, int, int) const {}
    __device__ __forceinline__ void operator()(const f32x4 (&acc)[2][2][4][2], const Unit& u, int wr, int wc, int fr, int fq) const {
        asm volatile("" : "+v"(fr), "+v"(fq));
        const int row0 = u.pm * BM + wr * 64 + fr, j0 = u.pn * HALF + wc * 32 + 8 * fq;
#pragma unroll
        for (int ai = 0; ai < 2; ++ai)
#pragma unroll
            for (int m = 0; m < 4; ++m) { const int row = row0 + ai * HALF + m * 16;
                const f32x4 p4 = *(const f32x4*)(SQ + (size_t)row * 16 + 4 * fq); float ss = (p4[0] + p4[1]) + (p4[2] + p4[3]);
                ss += __shfl_xor(ss, 16); ss += __shfl_xor(ss, 32);
                const float rstd = 1.0f / sqrtf(ss * (1.0f / 1024.0f) + eps);
                float o[8];
#pragma unroll
                for (int n = 0; n < 2; ++n)
#pragma unroll
                    for (int i = 0; i < 4; ++i) { const float gt = acc[ai][0][m][n][i] * rstd, up = acc[ai][1][m][n][i] * rstd; o[n * 4 + i] = gt * sigmoid_f(gt) * up; }
                u32x4 w; w.x = cvt_pk_bf16(o[0], o[1]); w.y = cvt_pk_bf16(o[2], o[3]); w.z = cvt_pk_bf16(o[4], o[5]); w.w = cvt_pk_bf16(o[6], o[7]);
                *(u32x4*)(ACT + (size_t)row * 2816 + j0) = w; }
    }
};

struct GateOrder {
    StaticOrder S1;
    __host__ __device__ void init(int M, int G_, int c_) { S1.init(M, 1024, G_, c_); }
    __host__ __device__ bool next(int i, Unit& u) const { Unit t; if (!S1.next(i >> 1, t)) return false; u.pm = t.pm; u.pn = 2 * t.pn + (i & 1); return true; }
    __device__ __forceinline__ void a_ready(const Unit&) const {}
    __device__ __forceinline__ void done(const Unit&) const {}
};

template <class Epi, class Sched, bool ALIGN_EPI = false, bool SP2 = false>
__device__ __forceinline__ void gemm_phase(PG8_LAS unsigned char* lds, const Gemm g, const Sched& S, const Epi& E) {
    const int tid = threadIdx.x, wid = __builtin_amdgcn_readfirstlane(tid >> 6), lane = tid & 63, wr = wid >> 2, wc = wid & 3, fr = lane & 15, fq = lane >> 4;
    const int K = g.K, nt = K / BK;
    unsigned voffA[2], voffB[2];
#pragma unroll
    for (int i = 0; i < 2; ++i) { int R, C; stage_rc(tid * 16 + i * 8192, R, C); const int Rb = Epi::PERM ? ((R & ~31) + perm32(R & 31)) : R;
        voffA[i] = (unsigned)(R * K + C) * 2u; voffB[i] = (unsigned)(Rb * K + C) * 2u; }
    const size_t kstep = (size_t)(BK * 2);
    const size_t hstep = (size_t)HALF * K * 2;
    const size_t tstep = 2 * hstep;
    const unsigned ldsw = (unsigned)wid * 1024u;
    const int aoff = lds_byte(wr * 64 + fr, fq * 8), boff = lds_byte(wc * 32 + fr, fq * 8);
#define PG8_SA(b, h) (((b) * 2 + (h)) * HTB)
#define PG8_SB(b, h) ((4 + (b) * 2 + (h)) * HTB)
#define PG8_STAGE(bufoff, gbase, voff) do { _Pragma("unroll") for (int _i = 0; _i < 2; ++_i) \
        __builtin_amdgcn_global_load_lds((const unsigned*)((const char*)(gbase) + (voff)[_i]), (PG8_LAS unsigned*)(lds + (bufoff) + ldsw + _i * 8192), 16, 0, 0); } while (0)
#define PG8_LDA(dst, b, h) do { _Pragma("unroll") for (int m = 0; m < 4; ++m) _Pragma("unroll") for (int k = 0; k < 2; ++k) dst[m][k] = *(const PG8_LAS bf16x8*)(lds + PG8_SA(b, h) + aoff + m * 2048 + k * 1024); } while (0)
#define PG8_LDB(dst, b, h) do { _Pragma("unroll") for (int n = 0; n < 2; ++n) _Pragma("unroll") for (int k = 0; k < 2; ++k) dst[n][k] = *(const PG8_LAS bf16x8*)(lds + PG8_SB(b, h) + boff + n * 2048 + k * 1024); } while (0)
#define PG8_MMA(ai, bj, At, Bt) do { __builtin_amdgcn_s_setprio(1); _Pragma("unroll") for (int m = 0; m < 4; ++m) _Pragma("unroll") for (int n = 0; n < 2; ++n) _Pragma("unroll") for (int k = 0; k < 2; ++k) \
        acc[ai][bj][m][n] = __builtin_amdgcn_mfma_f32_16x16x32_bf16(Bt[n][k], At[m][k], acc[ai][bj][m][n], 0, 0, 0); __builtin_amdgcn_s_setprio(0); } while (0)
#define PG8_WAIT_V(n) asm volatile("s_waitcnt vmcnt(" #n ")" ::: "memory")
#define PG8_WAIT_L(n) asm volatile("s_waitcnt lgkmcnt(" #n ")" ::: "memory")
#define PG8_BAR __builtin_amdgcn_s_barrier()
#define PG8_SCHED __builtin_amdgcn_sched_barrier(0)
    Unit cur, nxt; int ui = 0;
    if (!S.next(0, cur)) return;
    f32x4 acc[2][2][4][2];
#pragma unroll
    for (int a = 0; a < 2; ++a)
#pragma unroll
        for (int b = 0; b < 2; ++b)
#pragma unroll
            for (int m = 0; m < 4; ++m)
#pragma unroll
                for (int n = 0; n < 2; ++n) acc[a][b][m][n] = (f32x4){0.f, 0.f, 0.f, 0.f};
    bf16x8 At[4][2], B0[2][2], B1[2][2];
    const char* cA = (const char*)g.A + (size_t)cur.pm * tstep; const char* cB = (const char*)g.Bt + (size_t)cur.pn * tstep;
    S.a_ready(cur);
    if constexpr (SP2) {
        PG8_STAGE(PG8_SB(0, 0), cB, voffB); PG8_STAGE(PG8_SB(0, 1), cB + hstep, voffB); PG8_STAGE(PG8_SA(0, 0), cA, voffA); PG8_STAGE(PG8_SA(0, 1), cA + hstep, voffA);
        if (wr == 1) PG8_BAR;
        PG8_WAIT_V(2); PG8_BAR;
        PG8_STAGE(PG8_SB(1, 0), cB + kstep, voffB); PG8_STAGE(PG8_SA(1, 0), cA + kstep, voffA); PG8_STAGE(PG8_SB(1, 1), cB + hstep + kstep, voffB);
        PG8_WAIT_V(6); PG8_BAR;
    } else {
        PG8_STAGE(PG8_SB(0, 0), cB, voffB); PG8_STAGE(PG8_SA(0, 0), cA, voffA); PG8_STAGE(PG8_SB(0, 1), cB + hstep, voffB); PG8_STAGE(PG8_SA(0, 1), cA + hstep, voffA);
        if (wr == 1) PG8_BAR;
        PG8_WAIT_V(4); PG8_BAR;
        PG8_STAGE(PG8_SB(1, 0), cB + kstep, voffB); PG8_STAGE(PG8_SA(1, 0), cA + kstep, voffA); PG8_STAGE(PG8_SB(1, 1), cB + hstep + kstep, voffB);
        PG8_WAIT_V(6); PG8_BAR;
    }
    for (;;) {
        const bool has_next = S.next(ui + 1, nxt);
        const char* nA = has_next ? (const char*)g.A + (size_t)nxt.pm * tstep : cA; const char* nB = has_next ? (const char*)g.Bt + (size_t)nxt.pn * tstep : cB;
        for (int t = 0; t < nt; t += 2) {
            if constexpr (Epi::HOOK_T >= 0) { if (t == Epi::HOOK_T) E.hook(acc, cur, wr, wc, fr, fq); }
            const bool last = (t == nt - 2);
            const char* a1 = cA + (size_t)(t + 1) * kstep;
            const char* a2 = last ? nA : cA + (size_t)(t + 2) * kstep; const char* b2 = last ? nB : cB + (size_t)(t + 2) * kstep;
            const char* a3 = a2 + kstep; const char* b3 = b2 + kstep;
            if (last && has_next) S.a_ready(nxt);
            if constexpr (SP2) {
            PG8_LDB(B0, 0, 0); PG8_LDB(B1, 0, 1); PG8_SCHED; PG8_LDA(At, 0, 0); PG8_STAGE(PG8_SA(1, 1), a1 + hstep, voffA);
            PG8_WAIT_V(8); PG8_WAIT_L(0); PG8_BAR; PG8_MMA(0, 0, At, B0); PG8_MMA(0, 1, At, B1); PG8_BAR; PG8_SCHED;
            PG8_LDA(At, 0, 1); PG8_STAGE(PG8_SB(0, 0), b2, voffB); PG8_STAGE(PG8_SB(0, 1), b2 + hstep, voffB); PG8_STAGE(PG8_SA(0, 0), a2, voffA);
            PG8_WAIT_V(8); PG8_WAIT_L(0); PG8_BAR; PG8_MMA(1, 0, At, B0); PG8_MMA(1, 1, At, B1); PG8_BAR; PG8_SCHED;
            PG8_LDB(B0, 1, 0); PG8_LDB(B1, 1, 1); PG8_SCHED; PG8_LDA(At, 1, 0); PG8_STAGE(PG8_SA(0, 1), a2 + hstep, voffA);
            PG8_WAIT_V(8); PG8_WAIT_L(0); PG8_BAR; PG8_MMA(0, 0, At, B0); PG8_MMA(0, 1, At, B1); PG8_BAR; PG8_SCHED;
            PG8_LDA(At, 1, 1); PG8_STAGE(PG8_SB(1, 0), b3, voffB); PG8_STAGE(PG8_SB(1, 1), b3 + hstep, voffB); PG8_STAGE(PG8_SA(1, 0), a3, voffA);
            PG8_WAIT_V(8); PG8_WAIT_L(0); PG8_BAR; PG8_MMA(1, 0, At, B0); PG8_MMA(1, 1, At, B1); PG8_BAR; PG8_SCHED;
            } else {
            PG8_LDB(B0, 0, 0); PG8_SCHED; PG8_LDA(At, 0, 0); PG8_STAGE(PG8_SA(1, 1), a1 + hstep, voffA);
            PG8_WAIT_L(8); PG8_BAR; PG8_WAIT_L(0); PG8_MMA(0, 0, At, B0); PG8_BAR; PG8_SCHED;
            PG8_LDB(B1, 0, 1); PG8_STAGE(PG8_SB(0, 0), b2, voffB);
            PG8_BAR; PG8_WAIT_L(0); PG8_MMA(0, 1, At, B1); PG8_BAR;
            PG8_LDA(At, 0, 1); PG8_STAGE(PG8_SA(0, 0), a2, voffA);
            PG8_BAR; PG8_WAIT_L(0); PG8_MMA(1, 0, At, B0); PG8_BAR; PG8_SCHED;
            PG8_STAGE(PG8_SB(0, 1), b2 + hstep, voffB);
            PG8_WAIT_V(6); PG8_BAR; PG8_MMA(1, 1, At, B1); PG8_BAR;
            PG8_LDB(B0, 1, 0); PG8_SCHED; PG8_LDA(At, 1, 0); PG8_STAGE(PG8_SA(0, 1), a2 + hstep, voffA);
            PG8_WAIT_L(8); PG8_BAR; PG8_WAIT_L(0); PG8_MMA(0, 0, At, B0); PG8_BAR; PG8_SCHED;
            PG8_LDB(B1, 1, 1); PG8_STAGE(PG8_SB(1, 0), b3, voffB);
            PG8_BAR; PG8_WAIT_L(0); PG8_MMA(0, 1, At, B1); PG8_BAR;
            PG8_LDA(At, 1, 1); PG8_STAGE(PG8_SA(1, 0), a3, voffA);
            PG8_BAR; PG8_WAIT_L(0); PG8_MMA(1, 0, At, B0); PG8_BAR; PG8_SCHED;
            PG8_STAGE(PG8_SB(1, 1), b3 + hstep, voffB);
            PG8_WAIT_V(6); PG8_BAR; PG8_MMA(1, 1, At, B1); PG8_BAR;
            }
        }
        if constexpr (ALIGN_EPI) { if (wr == 0) PG8_BAR; }
        if constexpr (!Epi::AFTER_DRAIN) { E(acc, cur, wr, wc, fr, fq); S.done(cur); }
        if (!has_next) break;
#pragma unroll
        for (int a = 0; a < 2; ++a)
#pragma unroll
            for (int b = 0; b < 2; ++b)
#pragma unroll
                for (int m = 0; m < 4; ++m)
#pragma unroll
                    for (int n = 0; n < 2; ++n) acc[a][b][m][n] = (f32x4){0.f, 0.f, 0.f, 0.f};
        cur = nxt; cA = nA; cB = nB; ++ui;
        if constexpr (ALIGN_EPI) { if (wr == 1) PG8_BAR; }
    }
    PG8_WAIT_V(0);
    if constexpr (!ALIGN_EPI) { if (wr == 0) PG8_BAR; }
    PG8_BAR;
    if constexpr (Epi::AFTER_DRAIN) { E.fused(acc, cur, wr, wc, fr, fq, lds, wid, lane); S.done(cur); }
#undef PG8_SA
#undef PG8_SB
#undef PG8_STAGE
#undef PG8_LDA
#undef PG8_LDB
#undef PG8_MMA
#undef PG8_WAIT_V
#undef PG8_WAIT_L
#undef PG8_BAR
#undef PG8_SCHED
}
}

#define GAS __attribute__((address_space(1)))
#define LAS __attribute__((address_space(3)))
typedef unsigned short bf16;
typedef unsigned v4u __attribute__((ext_vector_type(4)));
typedef float f32x4 __attribute__((ext_vector_type(4)));
typedef short bf16x8 __attribute__((ext_vector_type(8)));
typedef GAS unsigned gu32;
typedef GAS unsigned long long gu64;
#define RLX_AGENT __ATOMIC_RELAXED, __HIP_MEMORY_SCOPE_AGENT
#define LDS_WAIT() asm volatile("s_waitcnt lgkmcnt(0)" ::: "memory")
#define VM_WAIT() asm volatile("s_waitcnt vmcnt(0)" ::: "memory")
__device__ __forceinline__ unsigned long long rt() { return __builtin_amdgcn_s_memrealtime(); }
__device__ __forceinline__ unsigned f2bf(float f) { unsigned u = __builtin_bit_cast(unsigned, f); return (u + 0x7fffu + ((u >> 16) & 1u)) >> 16; }
__device__ __forceinline__ unsigned pk2(float lo, float hi) { return f2bf(lo) | (f2bf(hi) << 16); }

#define XB_TMO      128
#define XB_XCNT(j)  (256  + 64 * (j))
#define XB_XSUB(j)  (1280 + 64 * (j))
#define XB_XGEN(j)  (2304 + 64 * (j))
#define XB_TOP      3328
#define XB_TOPGEN   3392
#define XCD_BAR_WORDS 3456
#define XB_SPIN_CAP (1u << 18)

__device__ __forceinline__ unsigned xb_ld(unsigned* p)              { return __hip_atomic_load(p, __ATOMIC_RELAXED, __HIP_MEMORY_SCOPE_AGENT); }
__device__ __forceinline__ unsigned xb_add(unsigned* p, unsigned v) { return __hip_atomic_fetch_add(p, v, __ATOMIC_RELAXED, __HIP_MEMORY_SCOPE_AGENT); }
__device__ __forceinline__ unsigned xb_xcc_id() { return (unsigned)__builtin_amdgcn_s_getreg((3 << 11) | 20) & 0xFu; }
#define XB_SPIN(cond, bar) do { unsigned _sp = 0; while (cond) { __builtin_amdgcn_s_sleep(1); \
    if ((++_sp & 255u) == 0u) { if (xb_ld(&(bar)[XB_TMO])) break; if (_sp > XB_SPIN_CAP) { atomicAdd(&(bar)[XB_TMO], 1u); break; } } } } while (0)

struct XcdBarrier {
    unsigned* bar; unsigned x;
    volatile LAS unsigned* st;
};

__device__ __forceinline__ XcdBarrier xcd_barrier_post(unsigned* bar, volatile LAS unsigned* st) {
    XcdBarrier b; b.bar = bar; b.x = xb_xcc_id(); b.st = st;
    if (threadIdx.x == 0) (void)xb_add(&bar[XB_XCNT(b.x)], 1u);
    return b;
}
__device__ __forceinline__ void xcd_barrier_complete(unsigned* bar, unsigned x, unsigned& nloc, unsigned& nx) {
    const unsigned G = gridDim.x * gridDim.y * gridDim.z;
    unsigned sum, cnt, mine, sp = 0u;
    for (;;) {
        sum = 0u; cnt = 0u; mine = 0u;
#pragma unroll
        for (unsigned j = 0; j < 16; ++j) { const unsigned c = xb_ld(&bar[XB_XCNT(j)]); sum += c; cnt += (c > 0u) ? 1u : 0u; mine = (j == x) ? c : mine; }
        if (sum == G) break;
        __builtin_amdgcn_s_sleep(1);
        if ((++sp & 255u) == 0u) { if (xb_ld(&bar[XB_TMO])) break; if (sp > XB_SPIN_CAP) { atomicAdd(&bar[XB_TMO], 1u); break; } }
    }
    nloc = mine > 0u ? mine : 1u; nx = cnt > 0u ? cnt : 1u;
}

__device__ __forceinline__ void xcd_barrier(const XcdBarrier& b) {
    asm volatile("s_waitcnt vmcnt(0)" ::: "memory");
    __syncthreads();
    if (threadIdx.x == 0) {
        unsigned* bar = b.bar;
        __builtin_amdgcn_s_waitcnt(0);
        unsigned nloc = b.st[0], nx = b.st[1];
        if (nloc == 0u) { xcd_barrier_complete(bar, b.x, nloc, nx); b.st[0] = nloc; b.st[1] = nx; }
        const unsigned old = xb_add(&bar[XB_XSUB(b.x)], 1u);
        const unsigned gen = old / nloc;
        if (old + 1u == (gen + 1u) * nloc) {
            __builtin_amdgcn_fence(__ATOMIC_RELEASE, "agent");
            asm volatile("s_waitcnt vmcnt(0)" ::: "memory");
            const unsigned og = xb_add(&bar[XB_TOP], 1u);
            const unsigned tg = og / nx;
            if (og + 1u == (tg + 1u) * nx) xb_add(&bar[XB_TOPGEN], 1u);
            else XB_SPIN(xb_ld(&bar[XB_TOPGEN]) == tg, bar);
            __builtin_amdgcn_fence(__ATOMIC_ACQUIRE, "agent");
            xb_add(&bar[XB_XGEN(b.x)], 1u);
            asm volatile("s_waitcnt vmcnt(0)" ::: "memory");
        } else {
            XB_SPIN(xb_ld(&bar[XB_XGEN(b.x)]) == gen, bar);
            __builtin_amdgcn_fence(__ATOMIC_ACQUIRE, "agent");
            asm volatile("s_waitcnt vmcnt(0)" ::: "memory");
        }
    }
    __syncthreads();
}


constexpr int NWAVES = 8;
#ifndef MK_N_LAUNCHES
#define MK_N_LAUNCHES 1
#endif
constexpr int PER_PHASE = 9;
constexpr int N_LAUNCHES = MK_N_LAUNCHES;

constexpr int BATCH = 4, SEQ = 8192, D = 1024, M = BATCH * SEQ, NP1 = 6656, NGATE = 2048, FF = 2816, FF2 = 5632, KCAT = 1536;
constexpr float NORM_EPS = 1e-6f;
constexpr int NHR = 3 * BATCH * 8 * SEQ;

constexpr size_t MiB = 1u << 20;
constexpr size_t WS_CTL = 0, CTL_ZERO_BYTES = 1 * MiB;
constexpr size_t WS_WIN = 2 * MiB;
constexpr size_t WS_WAB = 19 * MiB;
constexpr size_t WS_WOUT = 22 * MiB;
constexpr size_t WS_WGU = 24 * MiB;
constexpr size_t WS_WDN = 35 * MiB;
constexpr size_t WS_GWS = 41 * MiB;
constexpr size_t WS_SQ1 = 42 * MiB;
constexpr size_t WS_SQ2 = 44 * MiB;
constexpr size_t WS_LSE = 46 * MiB;
constexpr size_t WS_R = 50 * MiB;
constexpr size_t WS_U = WS_R, WS_VG = WS_R + 64 * MiB, WS_Q = WS_R + 128 * MiB, WS_K = WS_R + 224 * MiB, WS_V = WS_R + 320 * MiB;
constexpr size_t WS_YCAT = WS_K;
constexpr size_t WS_SG = WS_R;
constexpr size_t WS_MRG = WS_V;
constexpr size_t WS_H1B = WS_K;
constexpr size_t WS_ACT = WS_R;
constexpr size_t WS_END = WS_R + 416 * MiB;

constexpr int RING_OFF = 0, RING_BYTES = 131072;
constexpr int LDSCTL_OFF = RING_BYTES, MISC_OFF = LDSCTL_OFF + 320;
constexpr int LDS_BYTES = 147456;
constexpr int CW_BAR = 4096;

struct Args { const float* in[15]; float* out; unsigned char* ws; int ph_lo, ph_hi; };

struct Frame {
    LAS unsigned char* lds;
    volatile LAS unsigned* MISC;
    gu32* ctl;
    int tid, lane, wave, vcu, G;
};

__device__ __forceinline__ float wave_sum(float v) {
#pragma unroll
    for (int o = 1; o < 64; o <<= 1) v += __shfl_xor(v, o);
    return v;
}
__device__ __forceinline__ float wave_max(float v) {
#pragma unroll
    for (int o = 1; o < 64; o <<= 1) v = fmaxf(v, __shfl_xor(v, o));
    return v;
}
__device__ __forceinline__ float bf2f(unsigned short h) { return __uint_as_float((unsigned)h << 16); }

__device__ __forceinline__ void p0_transpose_item(const float* W, int K, int N, int ncol0, bf16* WT, int ldk, int k_off, int mode, int row_off, const float* kscale, LAS float* scr, int item, int nblk, int lane) {
    const int kb = item / nblk, nb = item % nblk, k0 = 64 * kb, n0 = 32 * nb;
#pragma unroll 8
    for (int i = 0; i < 32; ++i) { const int kk = 2 * i + (lane >> 5); float v = W[(size_t)(k0 + kk) * N + ncol0 + n0 + (lane & 31)]; if (kscale) v *= kscale[k0 + kk]; scr[kk * 33 + (lane & 31)] = v; }
    LDS_WAIT(); asm volatile("" ::: "memory");
    const int c = lane & 7; const int drow0 = mode == 0 ? row_off + n0 : ((n0 >> 7) << 8) + (n0 & 127) + row_off;
#pragma unroll
    for (int j = 0; j < 4; ++j) { const int n = (lane >> 3) + 8 * j; const LAS float* s = scr + (8 * c) * 33 + n;
        v4u o; o.x = pk2(s[0 * 33], s[1 * 33]); o.y = pk2(s[2 * 33], s[3 * 33]); o.z = pk2(s[4 * 33], s[5 * 33]); o.w = pk2(s[6 * 33], s[7 * 33]);
        *(GAS v4u*)(WT + (size_t)(drow0 + n) * ldk + k_off + k0 + 8 * c) = o; }
    LDS_WAIT(); asm volatile("" ::: "memory");
}
__device__ __forceinline__ void p0_prologue(Frame& F, const Args& a) {
    unsigned char* ws = a.ws;
    LAS float* scr = (LAS float*)(F.lds + RING_OFF + F.wave * 16384);
    const int gw = F.vcu * NWAVES + F.wave, NGW = F.G * NWAVES;
    constexpr int I_P1 = 16 * (NP1 / 32), I_G = 16 * (1024 / 32), I_A = 16 * 32, I_B = 8 * 32, I_O = 16 * 32, I_F = 16 * (FF / 32), I_D = (FF / 64) * 32;
    constexpr int NITEMS = I_P1 + 2 * I_G + I_A + I_B + I_O + 2 * I_F + I_D;
    const float* w_in = a.in[2];
    for (int it = gw; it < NITEMS; it += NGW) {
        int r = it;
        if (r < I_P1) { p0_transpose_item(w_in, D, 8704, 0, (bf16*)(ws + WS_WIN), D, 0, 0, 0, nullptr, scr, r, NP1 / 32, F.lane); continue; } r -= I_P1;
        if (r < I_G) { p0_transpose_item(w_in, D, 8704, 6656, (bf16*)(ws + WS_WIN), D, 0, 1, 6656, nullptr, scr, r, 32, F.lane); continue; } r -= I_G;
        if (r < I_G) { p0_transpose_item(w_in, D, 8704, 7680, (bf16*)(ws + WS_WIN), D, 0, 1, 6656 + 128, nullptr, scr, r, 32, F.lane); continue; } r -= I_G;
        if (r < I_A) { p0_transpose_item(a.in[7], 1024, 1024, 0, (bf16*)(ws + WS_WAB), KCAT, 0, 0, 0, nullptr, scr, r, 32, F.lane); continue; } r -= I_A;
        if (r < I_B) { p0_transpose_item(a.in[8], 512, 1024, 0, (bf16*)(ws + WS_WAB), KCAT, 1024, 0, 0, nullptr, scr, r, 32, F.lane); continue; } r -= I_B;
        if (r < I_O) { p0_transpose_item(a.in[9], 1024, 1024, 0, (bf16*)(ws + WS_WOUT), D, 0, 0, 0, nullptr, scr, r, 32, F.lane); continue; } r -= I_O;
        if (r < I_F) { p0_transpose_item(a.in[11], D, FF, 0, (bf16*)(ws + WS_WGU), D, 0, 1, 0, a.in[10], scr, r, FF / 32, F.lane); continue; } r -= I_F;
        if (r < I_F) { p0_transpose_item(a.in[12], D, FF, 0, (bf16*)(ws + WS_WGU), D, 0, 1, 128, a.in[10], scr, r, FF / 32, F.lane); continue; } r -= I_F;
        p0_transpose_item(a.in[13], FF, D, 0, (bf16*)(ws + WS_WDN), FF, 0, 0, 0, nullptr, scr, r, 32, F.lane);
    }
    { const float* gws = a.in[5]; bf16* o = (bf16*)(ws + WS_GWS); const int gt = F.vcu * (NWAVES * 64) + F.tid, NT = F.G * NWAVES * 64;
      for (int i = gt; i < 8 * 128 * 128 / 2; i += NT) ((GAS unsigned*)o)[i] = pk2(gws[2 * i], gws[2 * i + 1]); }
    { const float* x = a.in[0]; const float* g = a.in[1]; bf16* XN = (bf16*)a.out;
      f32x4 gv[4];
#pragma unroll
      for (int j = 0; j < 4; ++j) gv[j] = *((const GAS f32x4*)g + F.lane + 64 * j);
      for (int m = gw; m < M; m += NGW) {
        const GAS f32x4* xr = (const GAS f32x4*)(x + (size_t)m * D) + F.lane; f32x4 v[4]; float s = 0.f;
#pragma unroll
        for (int j = 0; j < 4; ++j) { v[j] = xr[64 * j]; s += (v[j].x * v[j].x + v[j].y * v[j].y) + (v[j].z * v[j].z + v[j].w * v[j].w); }
        const float rstd = 1.f / sqrtf(wave_sum(s) * (1.f / D) + NORM_EPS);
        GAS unsigned long long* o8 = (GAS unsigned long long*)(XN + (size_t)m * D) + F.lane;
#pragma unroll
        for (int j = 0; j < 4; ++j) o8[64 * j] = (unsigned long long)pk2(v[j].x * rstd * gv[j].x, v[j].y * rstd * gv[j].y) | ((unsigned long long)pk2(v[j].z * rstd * gv[j].z, v[j].w * rstd * gv[j].w) << 32);
      } }
}

__device__ __forceinline__ void attn_simple(Frame& F, bf16* Qb, const bf16* Kb, const bf16* Vb, float* LSE) {
    const int gw = F.vcu * NWAVES + F.wave, NGW = F.G * NWAVES, lane = F.lane;
    for (int R = gw; R < NHR; R += NGW) {
        const int g = R >> 18, rem = R & 262143, b = rem >> 16, h = (rem >> 13) & 7, p = rem & 8191;
        const int dlog = 2 * g, L = 8192 >> dlog, l = p & (L - 1), r = p >> (13 - dlog);
        const int seq0 = R - l;
        const float slope2 = __builtin_amdgcn_exp2f(-(float)(g * 8 + h + 1) * (1.0f / 3.0f)) * (float)(1 << dlog) * 1.4426950408889634f;
        float q[64];
        { const GAS v4u* qp = (const GAS v4u*)(Qb + (size_t)R * 64);
#pragma unroll
          for (int c = 0; c < 8; ++c) { const v4u w = qp[c];
            q[8 * c + 0] = __uint_as_float(w.x << 16); q[8 * c + 1] = __uint_as_float(w.x & 0xffff0000u); q[8 * c + 2] = __uint_as_float(w.y << 16); q[8 * c + 3] = __uint_as_float(w.y & 0xffff0000u);
            q[8 * c + 4] = __uint_as_float(w.z << 16); q[8 * c + 5] = __uint_as_float(w.z & 0xffff0000u); q[8 * c + 6] = __uint_as_float(w.w << 16); q[8 * c + 7] = __uint_as_float(w.w & 0xffff0000u); } }
        float s[3]; bool ok[3];
#pragma unroll
        for (int ps = 0; ps < 3; ++ps) {
            const int j = lane + 64 * ps - 64, kl = l + j; ok[ps] = (j <= 64) && (kl >= 0) && (kl < L);
            const int klc = kl < 0 ? 0 : (kl > L - 1 ? L - 1 : kl);
            const GAS v4u* kp = (const GAS v4u*)(Kb + (size_t)(seq0 + klc) * 64); float acc = 0.f;
#pragma unroll
            for (int c = 0; c < 8; ++c) { const v4u w = kp[c];
                acc += q[8 * c + 0] * __uint_as_float(w.x << 16) + q[8 * c + 1] * __uint_as_float(w.x & 0xffff0000u) + q[8 * c + 2] * __uint_as_float(w.y << 16) + q[8 * c + 3] * __uint_as_float(w.y & 0xffff0000u)
                     + q[8 * c + 4] * __uint_as_float(w.z << 16) + q[8 * c + 5] * __uint_as_float(w.z & 0xffff0000u) + q[8 * c + 6] * __uint_as_float(w.w << 16) + q[8 * c + 7] * __uint_as_float(w.w & 0xffff0000u); }
            const float aj = (float)(j < 0 ? -j : j);
            s[ps] = ok[ps] ? acc - slope2 * aj : -1e30f;
        }
        const float mx = wave_max(fmaxf(fmaxf(s[0], s[1]), s[2]));
        float pr[3]; float ls = 0.f;
#pragma unroll
        for (int ps = 0; ps < 3; ++ps) { pr[ps] = ok[ps] ? __builtin_amdgcn_exp2f(s[ps] - mx) : 0.f; ls += pr[ps]; }
        ls = wave_sum(ls);
        float o = 0.f;
#pragma unroll
        for (int ps = 0; ps < 3; ++ps) {
            const int nj = ps == 2 ? 1 : 64;
            for (int jj = 0; jj < nj; ++jj) {
                const float pj = __uint_as_float((unsigned)__builtin_amdgcn_readlane((int)__float_as_uint(pr[ps]), jj));
                int kl = l + jj + 64 * ps - 64; kl = kl < 0 ? 0 : (kl > L - 1 ? L - 1 : kl);
                o += pj * bf2f(Vb[(size_t)(seq0 + kl) * 64 + lane]);
            }
        }
        o = o / ls;
        Qb[(size_t)R * 64 + lane] = (bf16)f2bf(o);
        if (lane == 0) { const int token = b * SEQ + (l << dlog) + r; LSE[((size_t)g * M + token) * 8 + h] = mx + __builtin_amdgcn_logf(ls); }
    }
}

namespace att {
typedef short bf16x8 __attribute__((ext_vector_type(8)));
typedef short s16x4 __attribute__((ext_vector_type(4)));
typedef float f32x16 __attribute__((ext_vector_type(16)));
typedef unsigned u32x2 __attribute__((ext_vector_type(2)));
typedef __attribute__((address_space(3))) const unsigned char* lds_cptr;
constexpr int IMG_ROWS = 384, LDS_K = 0, LDS_V = IMG_ROWS * 128;
__device__ __forceinline__ int sw(int row) { return (((row >> 1) & 1) << 2) | (((row >> 2) & 1) << 1) | ((row >> 3) & 1); }
__device__ __forceinline__ void glds16(const void* gsrc, unsigned lds_dst) { unsigned keep;
    asm volatile("s_mov_b32 %0, m0\n\ts_mov_b32 m0, %2\n\ts_nop 0\n\tglobal_load_lds_dwordx4 %1, off\n\ts_mov_b32 m0, %0" : "=&s"(keep) : "v"(gsrc), "s"(lds_dst) : "memory"); }
__device__ __forceinline__ s16x4 vtr(lds_cptr p) { typedef short v4i16_t __attribute__((ext_vector_type(4))); return __builtin_bit_cast(s16x4, __builtin_amdgcn_ds_read_tr16_b64_v4i16((__attribute__((address_space(3))) v4i16_t*)p)); }
__device__ __forceinline__ unsigned cvtpk(float lo, float hi) { typedef float f2 __attribute__((ext_vector_type(2))); typedef __bf16 b2 __attribute__((ext_vector_type(2))); f2 v = {lo, hi}; b2 b = __builtin_convertvector(v, b2); return __builtin_bit_cast(unsigned, b); }

__device__ __forceinline__ void attn_phase(LAS unsigned char* lds, int vcu, int G, unsigned short* Qb, const unsigned short* Kb, const unsigned short* Vb, float* LSE) {
    int tid_ = threadIdx.x; asm volatile("" : "+v"(tid_));
    const int lane = tid_ & 63, w = __builtin_amdgcn_readfirstlane(tid_ >> 6), ql = lane & 31, hi = lane >> 5;
    const unsigned lds0 = (unsigned)(uintptr_t)lds;
    const lds_cptr L3 = (lds_cptr)lds;
    const int swl = sw(ql);
    int koff[4];
#pragma unroll
    for (int d0 = 0; d0 < 4; ++d0) koff[d0] = LDS_K + (32 * w + ql) * 128 + (((2 * d0 + hi) ^ swl) << 4);
    const int p_ = lane & 3, qrow = (lane & 15) >> 2, gi = (lane >> 4) & 1;
    const int sw0 = ((qrow >> 1) << 2) | (hi << 1);
    int voff[2][2];
#pragma unroll
    for (int dh = 0; dh < 2; ++dh)
#pragma unroll
        for (int sec = 0; sec < 2; ++sec) voff[dh][sec] = LDS_V + (32 * w + 4 * hi + qrow + 8 * sec) * 128 + (((4 * dh + 2 * gi + (p_ >> 1)) ^ (sw0 | sec)) << 4) + (p_ & 1) * 8;
    const float fbase = (float)(4 * hi - ql - 64);
    constexpr int NUNITS = 3 * 4 * 8 * 8192 / 256;
    for (int U = vcu; U < NUNITS; U += G) {
        const int R0 = U * 256, g = R0 >> 18, rem = R0 & 262143, b = rem >> 16, h = (rem >> 13) & 7, p0 = rem & 8191;
        const int dlog = 2 * g, L = 8192 >> dlog, l0 = p0 & (L - 1), r = p0 >> (13 - dlog), seq0 = R0 - l0;
        const float slope2 = __builtin_amdgcn_exp2f(-(float)(g * 8 + h + 1) * (1.0f / 3.0f)) * (float)(1 << dlog) * 1.4426950408889634f;
        __syncthreads();
#pragma unroll
        for (int i = 0; i < 6; ++i) { const int pc = w * 6 + i, row = 8 * pc + (lane >> 3); int ls = l0 - 64 + row; ls = ls < 0 ? 0 : (ls > L - 1 ? L - 1 : ls);
            const size_t eo = (size_t)(seq0 + ls) * 64 + (size_t)(((lane & 7) ^ sw(row)) << 3);
            glds16(Kb + eo, (unsigned)__builtin_amdgcn_readfirstlane(lds0 + LDS_K + pc * 1024));
            glds16(Vb + eo, (unsigned)__builtin_amdgcn_readfirstlane(lds0 + LDS_V + pc * 1024)); }
        bf16x8 qr[4];
        { const unsigned short* qp = Qb + (size_t)(R0 + 32 * w + ql) * 64 + 8 * hi;
#pragma unroll
          for (int d0 = 0; d0 < 4; ++d0) qr[d0] = *(const bf16x8*)(qp + 16 * d0); }
        asm volatile("s_waitcnt vmcnt(0)" ::: "memory");
        __syncthreads();
        f32x16 p[5];
#pragma unroll
        for (int t = 0; t < 5; ++t) {
            p[t] = (f32x16){0.f, 0.f, 0.f, 0.f, 0.f, 0.f, 0.f, 0.f, 0.f, 0.f, 0.f, 0.f, 0.f, 0.f, 0.f, 0.f};
#pragma unroll
            for (int d0 = 0; d0 < 4; ++d0) { const bf16x8 kf = *(const __attribute__((address_space(3))) bf16x8*)(L3 + koff[d0] + t * 4096); p[t] = __builtin_amdgcn_mfma_f32_32x32x16_bf16(kf, qr[d0], p[t], 0, 0, 0); }
        }
        const int kv0 = l0 + 32 * w - 64;
        float mx = -INFINITY;
#pragma unroll
        for (int t = 0; t < 5; ++t) {
            const bool tv = (kv0 + 32 * t >= 0) && (kv0 + 32 * t + 31 < L);
#pragma unroll
            for (int r16 = 0; r16 < 16; ++r16) { const float fd = fbase + (float)(32 * t + (r16 & 3) + 8 * (r16 >> 2));
                float s = __builtin_fmaf(-slope2, __builtin_fabsf(fd), p[t][r16]);
                if (t == 0) s = (fd >= -64.0f) ? s : -INFINITY;
                if (t == 4) s = (fd <= 64.0f) ? s : -INFINITY;
                s = tv ? s : -INFINITY;
                p[t][r16] = s; mx = fmaxf(mx, s); }
        }
        mx = fmaxf(mx, __shfl_xor(mx, 32));
        float lsum = 0.f;
#pragma unroll
        for (int t = 0; t < 5; ++t)
#pragma unroll
            for (int r16 = 0; r16 < 16; ++r16) { const float e = __builtin_amdgcn_exp2f(p[t][r16] - mx); p[t][r16] = e; lsum += e; }
        lsum += __shfl_xor(lsum, 32);
        f32x16 o[2];
        o[0] = (f32x16){0.f, 0.f, 0.f, 0.f, 0.f, 0.f, 0.f, 0.f, 0.f, 0.f, 0.f, 0.f, 0.f, 0.f, 0.f, 0.f}; o[1] = o[0];
#pragma unroll
        for (int t = 0; t < 5; ++t)
#pragma unroll
            for (int s2 = 0; s2 < 2; ++s2) {
                typedef unsigned u32x4 __attribute__((ext_vector_type(4)));
                u32x4 pw; pw.x = cvtpk(p[t][8 * s2 + 0], p[t][8 * s2 + 1]); pw.y = cvtpk(p[t][8 * s2 + 2], p[t][8 * s2 + 3]); pw.z = cvtpk(p[t][8 * s2 + 4], p[t][8 * s2 + 5]); pw.w = cvtpk(p[t][8 * s2 + 6], p[t][8 * s2 + 7]);
                const bf16x8 pf = __builtin_bit_cast(bf16x8, pw);
#pragma unroll
                for (int dh = 0; dh < 2; ++dh) { const s16x4 a = vtr(L3 + voff[dh][0] + t * 4096 + s2 * 2048), c = vtr(L3 + voff[dh][1] + t * 4096 + s2 * 2048);
                    const bf16x8 vf = (bf16x8){a[0], a[1], a[2], a[3], c[0], c[1], c[2], c[3]};
                    o[dh] = __builtin_amdgcn_mfma_f32_32x32x16_bf16(vf, pf, o[dh], 0, 0, 0); }
            }
        const float rl = 1.0f / lsum;
        unsigned short* op = Qb + (size_t)(R0 + 32 * w + ql) * 64 + 4 * hi;
#pragma unroll
        for (int dh = 0; dh < 2; ++dh)
#pragma unroll
            for (int k4 = 0; k4 < 4; ++k4) { u32x2 v; v.x = cvtpk(o[dh][4 * k4 + 0] * rl, o[dh][4 * k4 + 1] * rl); v.y = cvtpk(o[dh][4 * k4 + 2] * rl, o[dh][4 * k4 + 3] * rl);
                *(u32x2*)(op + 32 * dh + 8 * k4) = v; }
        if (hi == 0) { const int l = l0 + 32 * w + ql, token = b * 8192 + (l << dlog) + r; LSE[((size_t)g * 32768 + token) * 8 + h] = mx + __builtin_amdgcn_logf(lsum); }
    }
    __syncthreads();
}
}

__device__ __forceinline__ void gmlp_merge_simple(Frame& F, const Args& a) {
    unsigned char* ws = a.ws;
    const bf16* U = (const bf16*)(ws + WS_U); const bf16* VG = (const bf16*)(ws + WS_VG); const bf16* Ob = (const bf16*)(ws + WS_Q); const float* LSE = (const float*)(ws + WS_LSE);
    const bf16* GWS = (const bf16*)(ws + WS_GWS); bf16* YC = (bf16*)(ws + WS_YCAT);
    const float* ln_g = a.in[3]; const float* ln_b = a.in[4]; const float* bs = a.in[6];
    LAS float* st = (LAS float*)(F.lds + RING_BYTES + 1024);
    LAS float* vn = (LAS float*)(F.lds);
    LAS float* wsl = (LAS float*)(F.lds + 65536);
    const int tid = F.tid, lane = F.lane, wave = F.wave;
    for (int ci = F.vcu; ci < M / 128; ci += F.G) {
        const int tok0 = ci * 128;
        for (int i = 0; i < 16; ++i) { const int tk = wave * 16 + i; const GAS v4u* rp = (const GAS v4u*)(VG + (size_t)(tok0 + tk) * 1024);
            float v[16];
#pragma unroll
            for (int j = 0; j < 2; ++j) { const v4u w = rp[lane + 64 * j];
                v[8 * j + 0] = __uint_as_float(w.x << 16); v[8 * j + 1] = __uint_as_float(w.x & 0xffff0000u); v[8 * j + 2] = __uint_as_float(w.y << 16); v[8 * j + 3] = __uint_as_float(w.y & 0xffff0000u);
                v[8 * j + 4] = __uint_as_float(w.z << 16); v[8 * j + 5] = __uint_as_float(w.z & 0xffff0000u); v[8 * j + 6] = __uint_as_float(w.w << 16); v[8 * j + 7] = __uint_as_float(w.w & 0xffff0000u); }
            float s = 0.f;
#pragma unroll
            for (int j = 0; j < 16; ++j) s += v[j];
            const float mean = wave_sum(s) * (1.0f / 1024.0f); float q = 0.f;
#pragma unroll
            for (int j = 0; j < 16; ++j) { const float d = v[j] - mean; q += d * d; }
            const float rstd = 1.0f / sqrtf(wave_sum(q) * (1.0f / 1024.0f) + NORM_EPS);
            if (lane == 0) { st[2 * tk] = mean; st[2 * tk + 1] = rstd; } }
        __syncthreads();
        for (int g = 0; g < 8; ++g) {
#pragma unroll
            for (int i = 0; i < 4; ++i) { const int idx = tid + 512 * i, s = idx >> 4, c8 = (idx & 15) * 8;
                const v4u w = *(const GAS v4u*)(VG + (size_t)(tok0 + s) * 1024 + 128 * g + c8); const float mean = st[2 * s], rstd = st[2 * s + 1];
                const float* lg = ln_g + 128 * g + c8; const float* lb = ln_b + 128 * g + c8; LAS float* d = vn + s * 128 + c8;
                d[0] = (__uint_as_float(w.x << 16) - mean) * rstd * lg[0] + lb[0]; d[1] = (__uint_as_float(w.x & 0xffff0000u) - mean) * rstd * lg[1] + lb[1];
                d[2] = (__uint_as_float(w.y << 16) - mean) * rstd * lg[2] + lb[2]; d[3] = (__uint_as_float(w.y & 0xffff0000u) - mean) * rstd * lg[3] + lb[3];
                d[4] = (__uint_as_float(w.z << 16) - mean) * rstd * lg[4] + lb[4]; d[5] = (__uint_as_float(w.z & 0xffff0000u) - mean) * rstd * lg[5] + lb[5];
                d[6] = (__uint_as_float(w.w << 16) - mean) * rstd * lg[6] + lb[6]; d[7] = (__uint_as_float(w.w & 0xffff0000u) - mean) * rstd * lg[7] + lb[7];
                const v4u x = *(const GAS v4u*)(GWS + (size_t)g * 16384 + (size_t)s * 128 + c8); LAS float* e = wsl + s * 128 + c8;
                e[0] = __uint_as_float(x.x << 16); e[1] = __uint_as_float(x.x & 0xffff0000u); e[2] = __uint_as_float(x.y << 16); e[3] = __uint_as_float(x.y & 0xffff0000u);
                e[4] = __uint_as_float(x.z << 16); e[5] = __uint_as_float(x.z & 0xffff0000u); e[6] = __uint_as_float(x.w << 16); e[7] = __uint_as_float(x.w & 0xffff0000u); }
            __syncthreads();
            const int c = tid & 127, tq = tid >> 7;
            float acc[32];
#pragma unroll
            for (int tt = 0; tt < 32; ++tt) acc[tt] = 0.f;
            for (int s = 0; s < 128; s += 4) {
                const float v0 = vn[(s + 0) * 128 + c], v1 = vn[(s + 1) * 128 + c], v2 = vn[(s + 2) * 128 + c], v3 = vn[(s + 3) * 128 + c];
#pragma unroll
                for (int tt = 0; tt < 32; ++tt) { const f32x4 w4 = *(const LAS f32x4*)(wsl + (32 * tq + tt) * 128 + s); acc[tt] += w4.x * v0 + w4.y * v1 + w4.z * v2 + w4.w * v3; }
            }
#pragma unroll
            for (int tt = 0; tt < 32; ++tt) { const int t = 32 * tq + tt; const size_t tok = (size_t)(tok0 + t);
                const float uu = bf2f(U[tok * 1024 + 128 * g + c]); YC[tok * KCAT + 128 * g + c] = (bf16)f2bf(uu * (acc[tt] + bs[g * 128 + t])); }
            __syncthreads();
        }
        for (int i = 0; i < 128; ++i) { const int idx = tid + 512 * i, tk = idx >> 9, ch = idx & 511, h = ch >> 6, dd = ch & 63; const int token = tok0 + tk, b = token >> 13, t = token & 8191;
            float ls[3], ov[3];
#pragma unroll
            for (int g = 0; g < 3; ++g) { const int dlog = 2 * g, r = t & ((1 << dlog) - 1), l = t >> dlog; const size_t hr = (size_t)(((g * 4 + b) * 8 + h) * 8192 + r * (8192 >> dlog) + l);
                ov[g] = bf2f(Ob[hr * 64 + dd]); ls[g] = LSE[((size_t)g * M + token) * 8 + h]; }
            const float mx = fmaxf(fmaxf(ls[0], ls[1]), ls[2]); const float w0 = __builtin_amdgcn_exp2f(ls[0] - mx), w1 = __builtin_amdgcn_exp2f(ls[1] - mx), w2 = __builtin_amdgcn_exp2f(ls[2] - mx);
            YC[(size_t)token * KCAT + 1024 + ch] = (bf16)f2bf((w0 * ov[0] + w1 * ov[1] + w2 * ov[2]) / (w0 + w1 + w2)); }
        __syncthreads();
    }
}

namespace gm {
typedef short bf16x8 __attribute__((ext_vector_type(8)));
typedef short s16x4 __attribute__((ext_vector_type(4)));
typedef float f32x4 __attribute__((ext_vector_type(4)));
typedef unsigned u32x4 __attribute__((ext_vector_type(4)));
typedef __attribute__((address_space(3))) const unsigned char* lds_cptr;
__device__ __forceinline__ s16x4 vtr(lds_cptr p) { typedef short v4i16_t __attribute__((ext_vector_type(4))); return __builtin_bit_cast(s16x4, __builtin_amdgcn_ds_read_tr16_b64_v4i16((__attribute__((address_space(3))) v4i16_t*)p)); }
__device__ __forceinline__ unsigned cvtpk(float lo, float hi) { typedef float f2 __attribute__((ext_vector_type(2))); typedef __bf16 b2 __attribute__((ext_vector_type(2))); f2 v = {lo, hi}; b2 b = __builtin_convertvector(v, b2); return __builtin_bit_cast(unsigned, b); }
__device__ __forceinline__ float lo16(unsigned w) { return __uint_as_float(w << 16); }
__device__ __forceinline__ float hi16(unsigned w) { return __uint_as_float(w & 0xffff0000u); }

struct GmlpArgs { const unsigned short *U, *VG, *Ob, *GWS; const float *LSE, *ln_g, *ln_b, *bs; unsigned short* YC; };

__device__ __forceinline__ void gmlp_phase(LAS unsigned char* lds, LAS float* st, int vcu, int G, const GmlpArgs& A) {
    int tid_ = threadIdx.x; asm volatile("" : "+v"(tid_));
    const int tid = tid_, lane = tid & 63, w = __builtin_amdgcn_readfirstlane(tid >> 6), fr = lane & 15, fq = lane >> 4;
    const lds_cptr L3 = (lds_cptr)lds;
    const int qq = (lane & 15) >> 2, p_ = lane & 3, f8 = qq | ((fq & 1) << 2);
    const int rbase = (8 * fq + qq) * 256 + 64 * p_ + (f8 << 3);
    for (int ci = vcu; ci < 256; ci += G) {
        const int tok0 = ci * 128;
        for (int i = 0; i < 16; ++i) { const int tk = w * 16 + i; const u32x4* rp = (const u32x4*)(A.VG + (size_t)(tok0 + tk) * 1024);
            float v[16];
#pragma unroll
            for (int j = 0; j < 2; ++j) { const u32x4 x = rp[lane + 64 * j];
                v[8 * j + 0] = lo16(x.x); v[8 * j + 1] = hi16(x.x); v[8 * j + 2] = lo16(x.y); v[8 * j + 3] = hi16(x.y); v[8 * j + 4] = lo16(x.z); v[8 * j + 5] = hi16(x.z); v[8 * j + 6] = lo16(x.w); v[8 * j + 7] = hi16(x.w); }
            float s = 0.f;
#pragma unroll
            for (int j = 0; j < 16; ++j) s += v[j];
#pragma unroll
            for (int o = 1; o < 64; o <<= 1) s += __shfl_xor(s, o);
            const float mean = s * (1.0f / 1024.0f); float q = 0.f;
#pragma unroll
            for (int j = 0; j < 16; ++j) { const float d = v[j] - mean; q += d * d; }
#pragma unroll
            for (int o = 1; o < 64; o <<= 1) q += __shfl_xor(q, o);
            if (lane == 0) { st[2 * tk] = mean; st[2 * tk + 1] = 1.0f / sqrtf(q * (1.0f / 1024.0f) + 1e-6f); } }
        __syncthreads();
        u32x4 raw[4];
#define GM_LOAD(g_) do { _Pragma("unroll") for (int i = 0; i < 4; ++i) { const int idx = tid + 512 * i, s = idx >> 4, ch = idx & 15; raw[i] = *(const u32x4*)(A.VG + (size_t)(tok0 + s) * 1024 + 128 * (g_) + 8 * ch); } } while (0)
#define GM_WRITE(g_, buf_) do { _Pragma("unroll") for (int i = 0; i < 4; ++i) { const int idx = tid + 512 * i, s = idx >> 4, ch = idx & 15; const float mean = st[2 * s], rstd = st[2 * s + 1]; \
            const f32x4 g0 = *(const f32x4*)(A.ln_g + 128 * (g_) + 8 * ch), g1 = *(const f32x4*)(A.ln_g + 128 * (g_) + 8 * ch + 4), b0 = *(const f32x4*)(A.ln_b + 128 * (g_) + 8 * ch), b1 = *(const f32x4*)(A.ln_b + 128 * (g_) + 8 * ch + 4); \
            const u32x4 x = raw[i]; \
            const unsigned w0 = cvtpk((lo16(x.x) - mean) * rstd * g0.x + b0.x, (hi16(x.x) - mean) * rstd * g0.y + b0.y), w1 = cvtpk((lo16(x.y) - mean) * rstd * g0.z + b0.z, (hi16(x.y) - mean) * rstd * g0.w + b0.w); \
            const unsigned w2 = cvtpk((lo16(x.z) - mean) * rstd * g1.x + b1.x, (hi16(x.z) - mean) * rstd * g1.y + b1.y), w3 = cvtpk((lo16(x.w) - mean) * rstd * g1.z + b1.z, (hi16(x.w) - mean) * rstd * g1.w + b1.w); \
            const int f = (s & 3) | (((s >> 3) & 1) << 2); const u32x4 o = (f & 1) ? (u32x4){w2, w3, w0, w1} : (u32x4){w0, w1, w2, w3}; \
            *(LAS u32x4*)(lds + (buf_) * 32768 + s * 256 + ((ch ^ (f >> 1)) << 4)) = o; } } while (0)
        bf16x8 wf[4];
#define GM_WS(g_) do { _Pragma("unroll") for (int ks = 0; ks < 4; ++ks) wf[ks] = *(const bf16x8*)(A.GWS + (size_t)(g_) * 16384 + (size_t)(16 * w + fr) * 128 + 32 * ks + 8 * fq); } while (0)
        GM_LOAD(0); GM_WRITE(0, 0);
        __syncthreads();
        for (int g = 0; g < 8; ++g) {
            GM_WS(g);
            if (g < 7) GM_LOAD(g + 1);
            f32x4 acc[8];
#pragma unroll
            for (int n = 0; n < 8; ++n) acc[n] = (f32x4){0.f, 0.f, 0.f, 0.f};
            const int tb = (g & 1) * 32768 + rbase;
#pragma unroll
            for (int ks = 0; ks < 4; ++ks)
#pragma unroll
                for (int n = 0; n < 8; ++n) { const int a0 = (tb ^ (n << 3)) + ks * 8192; const s16x4 x = vtr(L3 + a0), y = vtr(L3 + a0 + 1024);
                    const bf16x8 vf = (bf16x8){x[0], x[1], x[2], x[3], y[0], y[1], y[2], y[3]};
                    acc[n] = __builtin_amdgcn_mfma_f32_16x16x32_bf16(vf, wf[ks], acc[n], 0, 0, 0); }
            { const int t = 16 * w + fr; const size_t tok = (size_t)(tok0 + t); const float bias = A.bs[g * 128 + t];
              const u32x4* up = (const u32x4*)(A.U + tok * 1024 + 128 * g + 32 * fq); u32x4* yp = (u32x4*)(A.YC + tok * 1536 + 128 * g + 32 * fq);
#pragma unroll
              for (int k = 0; k < 4; ++k) { const u32x4 u = up[k]; const f32x4 a = acc[2 * k], b = acc[2 * k + 1]; u32x4 o;
                  o.x = cvtpk(lo16(u.x) * (a.x + bias), hi16(u.x) * (a.y + bias)); o.y = cvtpk(lo16(u.y) * (a.z + bias), hi16(u.y) * (a.w + bias));
                  o.z = cvtpk(lo16(u.z) * (b.x + bias), hi16(u.z) * (b.y + bias)); o.w = cvtpk(lo16(u.w) * (b.z + bias), hi16(u.w) * (b.w + bias)); yp[k] = o; } }
            if (g < 7) GM_WRITE(g + 1, (g + 1) & 1);
            __syncthreads();
        }
#undef GM_LOAD
#undef GM_WRITE
#undef GM_WS
        for (int i = 0; i < 16; ++i) { const int idx = tid + 512 * i, tk = idx >> 6, h = (idx >> 3) & 7, d8 = idx & 7; const int token = tok0 + tk, b = token >> 13, t = token & 8191;
            float ls[3]; u32x4 ov[3];
#pragma unroll
            for (int g = 0; g < 3; ++g) { const int dlog = 2 * g, r = t & ((1 << dlog) - 1), l = t >> dlog; const size_t hr = (size_t)(((g * 4 + b) * 8 + h) * 8192 + r * (8192 >> dlog) + l);
                ov[g] = *(const u32x4*)(A.Ob + hr * 64 + 8 * d8); ls[g] = A.LSE[((size_t)g * 32768 + token) * 8 + h]; }
            const float mx = fmaxf(fmaxf(ls[0], ls[1]), ls[2]); float w0 = __builtin_amdgcn_exp2f(ls[0] - mx), w1 = __builtin_amdgcn_exp2f(ls[1] - mx), w2 = __builtin_amdgcn_exp2f(ls[2] - mx);
            const float inv = 1.0f / (w0 + w1 + w2); w0 *= inv; w1 *= inv; w2 *= inv;
            u32x4 o;
            o.x = cvtpk(w0 * lo16(ov[0].x) + w1 * lo16(ov[1].x) + w2 * lo16(ov[2].x), w0 * hi16(ov[0].x) + w1 * hi16(ov[1].x) + w2 * hi16(ov[2].x));
            o.y = cvtpk(w0 * lo16(ov[0].y) + w1 * lo16(ov[1].y) + w2 * lo16(ov[2].y), w0 * hi16(ov[0].y) + w1 * hi16(ov[1].y) + w2 * hi16(ov[2].y));
            o.z = cvtpk(w0 * lo16(ov[0].z) + w1 * lo16(ov[1].z) + w2 * lo16(ov[2].z), w0 * hi16(ov[0].z) + w1 * hi16(ov[1].z) + w2 * hi16(ov[2].z));
            o.w = cvtpk(w0 * lo16(ov[0].w) + w1 * lo16(ov[1].w) + w2 * lo16(ov[2].w), w0 * hi16(ov[0].w) + w1 * hi16(ov[1].w) + w2 * hi16(ov[2].w));
            *(u32x4*)(A.YC + (size_t)token * 1536 + 1024 + 64 * h + 8 * d8) = o; }
        __syncthreads();
    }
}
}

__device__ __forceinline__ void final_norm(Frame& F, const Args& a) {
    const float* SQ = (const float*)(a.ws + WS_SQ2); const float* g = a.in[14]; float* out = a.out;
    const int gw = F.vcu * NWAVES + F.wave, NGW = F.G * NWAVES;
    f32x4 gv[4];
#pragma unroll
    for (int j = 0; j < 4; ++j) gv[j] = *((const GAS f32x4*)g + F.lane + 64 * j);
    for (int m = gw; m < M; m += NGW) {
        float s = F.lane < 16 ? SQ[(size_t)m * 16 + F.lane] : 0.f; s = wave_sum(s);
        const float rstd = 1.f / sqrtf(s * (1.f / D) + NORM_EPS);
        GAS f32x4* xr = (GAS f32x4*)(out + (size_t)m * D) + F.lane;
#pragma unroll
        for (int j = 0; j < 4; ++j) { const f32x4 v = xr[64 * j]; xr[64 * j] = v * rstd * gv[j]; }
    }
}

__global__ void __launch_bounds__(NWAVES * 64, 2) mk_fwd(Args args) {
    extern __shared__ __attribute__((aligned(16))) unsigned char lds[];
    Frame F;
    F.lds = (LAS unsigned char*)lds;
    F.MISC = (volatile LAS unsigned*)(F.lds + MISC_OFF);
#define REFRAME() do { int t_ = threadIdx.x; asm volatile("" : "+v"(t_)); F.tid = t_; F.lane = t_ & 63; F.wave = __builtin_amdgcn_readfirstlane(t_ >> 6); } while (0)
    REFRAME();
    F.G = gridDim.x; { const int bx = blockIdx.x; F.vcu = (F.G % 8 == 0) ? (bx % 8) * (F.G / 8) + bx / 8 : bx; }
    unsigned char* ws = args.ws;
    F.ctl = (gu32*)(ws + WS_CTL);
    for (int u = F.tid; u < (LDS_BYTES - LDSCTL_OFF) / 4; u += NWAVES * 64) ((LAS unsigned*)(F.lds + LDSCTL_OFF))[u] = 0u;
    __syncthreads();
    XcdBarrier bar; bar.bar = (unsigned*)(F.ctl + CW_BAR); bar.x = 0; bar.st = nullptr;
    if (N_LAUNCHES != PER_PHASE) bar = xcd_barrier_post((unsigned*)(F.ctl + CW_BAR), F.MISC + 8);
#define GRID_BAR() do { if (N_LAUNCHES != PER_PHASE) xcd_barrier(bar); } while (0)
    const int lo = args.ph_lo, hi = args.ph_hi;
#define IN(k) (lo <= (k) && (k) < hi)
#define BOTH(k) (IN(k) && IN((k) + 1))
    bf16* XN = (bf16*)args.out;
    bf16* WIN = (bf16*)(ws + WS_WIN);

    if (IN(0)) { p0_prologue(F, args); if (BOTH(0)) GRID_BAR(); }

    if (IN(1)) {
        pg8::Gemm g{XN, WIN, M, NP1, D}; pg8::StaticOrder S; S.init(M, NP1, F.G, (int)blockIdx.x);
        pg8::EpiProj E{(bf16*)(ws + WS_R)};
        pg8::gemm_phase<pg8::EpiProj, pg8::StaticOrder, true, true>(F.lds + RING_OFF, g, S, E);
        if (BOTH(1)) GRID_BAR();
    }
    if (IN(2)) { att::attn_phase(F.lds + RING_OFF, F.vcu, F.G, (bf16*)(ws + WS_Q), (const bf16*)(ws + WS_K), (const bf16*)(ws + WS_V), (float*)(ws + WS_LSE)); if (BOTH(2)) GRID_BAR(); }
    if (IN(3)) { const gm::GmlpArgs GA{(const bf16*)(ws + WS_U), (const bf16*)(ws + WS_VG), (const bf16*)(ws + WS_Q), (const bf16*)(ws + WS_GWS), (const float*)(ws + WS_LSE), args.in[3], args.in[4], args.in[6], (bf16*)(ws + WS_YCAT)};
        gm::gmlp_phase(F.lds + RING_OFF, (LAS float*)(F.lds + RING_BYTES + 1024), F.vcu, F.G, GA); if (BOTH(3)) GRID_BAR(); }
    if (IN(4)) {
        { pg8::Gemm g{XN, WIN + (size_t)NP1 * D, M, NGATE, D}; pg8::GateOrder S; S.init(M, F.G, (int)blockIdx.x);
          pg8::EpiGate E{(bf16*)(ws + WS_SG)};
          pg8::gemm_phase<pg8::EpiGate, pg8::GateOrder, true, true>(F.lds + RING_OFF, g, S, E); }
        { pg8::Gemm g{(const bf16*)(ws + WS_YCAT), (const bf16*)(ws + WS_WAB), M, D, KCAT}; pg8::StaticOrder S; S.init(M, D, F.G, (int)blockIdx.x);
          pg8::EpiMerge E{(const bf16*)(ws + WS_SG), (bf16*)(ws + WS_MRG)};
          pg8::gemm_phase<pg8::EpiMerge, pg8::StaticOrder, true, true>(F.lds + RING_OFF, g, S, E); }
        if (BOTH(4)) GRID_BAR();
    }
    if (IN(5)) {
        pg8::Gemm g{(const bf16*)(ws + WS_MRG), (const bf16*)(ws + WS_WOUT), M, D, D}; pg8::StaticOrder S; S.init(M, D, F.G, (int)blockIdx.x);
        pg8::EpiRes E{args.in[0], args.out, (bf16*)(ws + WS_H1B), (float*)(ws + WS_SQ1)};
        pg8::gemm_phase<pg8::EpiRes, pg8::StaticOrder, true, true>(F.lds + RING_OFF, g, S, E);
        if (BOTH(5)) GRID_BAR();
    }
    if (IN(6)) {
        pg8::Gemm g{(const bf16*)(ws + WS_H1B), (const bf16*)(ws + WS_WGU), M, FF2, D}; pg8::StaticOrder S; S.init(M, FF2, F.G, (int)blockIdx.x);
        pg8::EpiSwiglu E{(const float*)(ws + WS_SQ1), (bf16*)(ws + WS_ACT), NORM_EPS};
        pg8::gemm_phase<pg8::EpiSwiglu, pg8::StaticOrder, true, true>(F.lds + RING_OFF, g, S, E);
        if (BOTH(6)) GRID_BAR();
    }
    if (IN(7)) {
        pg8::Gemm g{(const bf16*)(ws + WS_ACT), (const bf16*)(ws + WS_WDN), M, D, FF}; pg8::StaticOrder S; S.init(M, D, F.G, (int)blockIdx.x);
        pg8::EpiRes E{args.out, args.out, nullptr, (float*)(ws + WS_SQ2)};
        pg8::gemm_phase<pg8::EpiRes, pg8::StaticOrder, true, true>(F.lds + RING_OFF, g, S, E);
        if (BOTH(7)) GRID_BAR();
    }
    if (IN(8)) { REFRAME(); final_norm(F, args); }
#undef IN
#undef BOTH
}

extern "C" void kernel_launch(void* const* d_in, const int* in_sizes, int n_in, void* d_out, int out_size, void* d_ws, size_t ws_size, hipStream_t stream) {
    static int grid = 0;
    if (grid == 0) {
        if (n_in != 15 || out_size != M * D || ws_size < WS_END) { fprintf(stderr, "kernel_launch: unexpected shapes: n_in %d out %d ws %zu (need >= %zu)\n", n_in, out_size, ws_size, (size_t)WS_END); grid = -1; return; }
        int dev = 0, cus = 0, per_cu = 0;
        if (hipGetDevice(&dev) != hipSuccess || hipDeviceGetAttribute(&cus, hipDeviceAttributeMultiprocessorCount, dev) != hipSuccess) { grid = -1; return; }
        if (hipFuncSetAttribute((const void*)mk_fwd, hipFuncAttributeMaxDynamicSharedMemorySize, LDS_BYTES) != hipSuccess) { fprintf(stderr, "kernel_launch: hipFuncSetAttribute failed\n"); grid = -1; return; }
        if (hipOccupancyMaxActiveBlocksPerMultiprocessor(&per_cu, (const void*)mk_fwd, NWAVES * 64, LDS_BYTES) != hipSuccess || per_cu < 1)
            fprintf(stderr, "kernel_launch: occupancy query reports %d workgroups per CU\n", per_cu);
        (void)hipGetLastError();
        grid = cus;
    }
    if (grid < 0) return;
    if (hipMemsetAsync((char*)d_ws + WS_CTL, 0, CTL_ZERO_BYTES, stream) != hipSuccess) { fprintf(stderr, "kernel_launch: hipMemsetAsync failed\n"); return; }
    Args a{};
    for (int i = 0; i < 15; ++i) a.in[i] = (const float*)d_in[i];
    a.out = (float*)d_out; a.ws = (unsigned char*)d_ws;
    for (int li = 0; li < N_LAUNCHES; ++li) {
        a.ph_lo = (N_LAUNCHES == PER_PHASE) ? li : 0; a.ph_hi = (N_LAUNCHES == PER_PHASE) ? li + 1 : PER_PHASE;
        hipLaunchKernelGGL(mk_fwd, dim3(grid), dim3(NWAVES * 64), LDS_BYTES, stream, a);
        const hipError_t le = hipPeekAtLastError();
        if (le != hipSuccess) { fprintf(stderr, "kernel_launch: launch %d failed: %s\n", li, hipGetErrorName(le)); break; }
    }
}
```

```cpp
#include <hip/hip_runtime.h>
#include <cstdio>
#include <cstdint>
namespace pg8 {
#define PG8_LAS __attribute__((address_space(3)))
typedef unsigned short bf16_t;
typedef short bf16x8 __attribute__((ext_vector_type(8)));
typedef float f32x4 __attribute__((ext_vector_type(4)));
typedef unsigned u32x4 __attribute__((ext_vector_type(4)));
constexpr int BM = 256, BK = 64, HALF = 128, HTB = HALF * BK * 2  , STAGE_BYTES = 8 * HTB, NXCD = 8, WGM = 8;

__host__ __device__ __forceinline__ int lds_byte(int r, int c) { const int st = (r >> 4) * 2 + (c >> 5), rr = r & 15, cc = c & 31, ob = rr * 64 + cc * 2; return st * 1024 + (ob ^ (((ob >> 9) & 1) << 5)); }
__host__ __device__ __forceinline__ void stage_rc(int b, int& R, int& C) { const int st = b / 1024, sb = b % 1024, swz = sb ^ (((sb >> 9) & 1) << 5); R = (st >> 1) * 16 + swz / 64; C = (st & 1) * 32 + (swz % 64) / 2; }
__host__ __device__ __forceinline__ int perm32(int rho) { const int n = rho >> 4, i = rho & 15; return 8 * (i >> 2) + 4 * n + (i & 3); }

struct Unit { int pm, pn; };
struct Gemm { const bf16_t* A; const bf16_t* Bt; int M, N, K; };

struct StaticOrder {
    int nM, nN, nwg, G, c;
    __host__ __device__ void init(int M, int N, int G_, int c_) { nM = M / BM; nN = N / BM; nwg = nM * nN; G = G_; c = c_; }
    __host__ __device__ bool next(int i, Unit& u) const {
        const long L = (long)i * G + c; if (L >= nwg) return false;
        int wgid = (int)L; { const int q = nwg / NXCD, r = nwg % NXCD, xcd = wgid % NXCD, off = wgid / NXCD; wgid = (xcd < r ? xcd * (q + 1) : r * (q + 1) + (xcd - r) * q) + off; }
        const int nig = WGM * nN, gid = wgid / nig, fm = gid * WGM, gsz = (nM - fm) < WGM ? (nM - fm) : WGM;
        u.pm = fm + ((wgid % nig) % gsz); u.pn = (wgid % nig) / gsz; return true;
    }
    __device__ __forceinline__ void a_ready(const Unit&) const {}
    __device__ __forceinline__ void done(const Unit&) const {}
};

__device__ __forceinline__ unsigned cvt_pk_bf16(float lo, float hi) { unsigned r; asm volatile("v_cvt_pk_bf16_f32 %0, %1, %2" : "=v"(r) : "v"(lo), "v"(hi)); return r; }
typedef float f32x2 __attribute__((ext_vector_type(2)));
__device__ __forceinline__ f32x2 gelu_pk(f32x2 v) {
    const f32x2 av = __builtin_elementwise_abs(v), d = av * 0.2316418882f + 1.0f;
    f32x2 t; t.x = __builtin_amdgcn_rcpf(d.x); t.y = __builtin_amdgcn_rcpf(d.y);
    f32x2 q = t * 0.5307027145f + (-0.7265760135f); q = q * t + 0.7107068705f; q = q * t + (-0.142248368f); q = q * t + 0.127414796f; q = q * t;
    const f32x2 s = (v * v) * (-0.72134752044f);
    f32x2 e; e.x = __builtin_amdgcn_exp2f(s.x); e.y = __builtin_amdgcn_exp2f(s.y);
    const f32x2 m = v * (q * e), r = v - m;
    f32x2 o; o.x = v.x < 0.f ? m.x : r.x; o.y = v.y < 0.f ? m.y : r.y; return o;
}


__device__ __forceinline__ float sigmoid_f(float x) { return __builtin_amdgcn_rcpf(1.0f + __builtin_amdgcn_exp2f(-1.4426950408889634f * x)); }
__device__ __forceinline__ float bf_lo(unsigned w) { return __uint_as_float(w << 16); }
__device__ __forceinline__ float bf_hi(unsigned w) { return __uint_as_float(w & 0xffff0000u); }
constexpr float QK_C2 = 0.125f * 1.4426950408889634f;

struct EpiProj {
    static constexpr bool PERM = true, AFTER_DRAIN = false; static constexpr int HOOK_T = -1;
    bf16_t* RB;
    __device__ __forceinline__ void hook(f32x4 (&)[2][2][4][2], const Unit&, int, int, int, int) const {}
    __device__ __forceinline__ void operator()(const f32x4 (&acc)[2][2][4][2], const Unit& u, int wr, int wc, int fr, int fq) const {
        asm volatile("" : "+v"(fr), "+v"(fq));
        const int pn = u.pn, row0 = u.pm * BM + wr * 64 + fr;
        if (pn < 8) {
            bf16_t* base = RB + (size_t)(pn >> 2) * (32u << 20); const int col0 = (pn & 3) * BM + wc * 32 + 8 * fq;
#pragma unroll
            for (int ai = 0; ai < 2; ++ai)
#pragma unroll
                for (int m = 0; m < 4; ++m) { bf16_t* rowp = base + (size_t)(row0 + ai * HALF + m * 16) * 1024 + col0;
#pragma unroll
                    for (int bj = 0; bj < 2; ++bj) { const f32x4 v0 = acc[ai][bj][m][0], v1 = acc[ai][bj][m][1];
                        const f32x2 a = gelu_pk((f32x2){v0[0], v0[1]}), b = gelu_pk((f32x2){v0[2], v0[3]}), c = gelu_pk((f32x2){v1[0], v1[1]}), d = gelu_pk((f32x2){v1[2], v1[3]});
                        u32x4 w; w.x = cvt_pk_bf16(a.x, a.y); w.y = cvt_pk_bf16(b.x, b.y); w.z = cvt_pk_bf16(c.x, c.y); w.w = cvt_pk_bf16(d.x, d.y);
                        *(u32x4*)(rowp + bj * HALF) = w; } }
        } else {
            const int t6 = pn - 8, which = t6 / 6, rem = t6 - which * 6, g = rem >> 1, half = rem & 1, dlog = 2 * g;
            bf16_t* base = RB + (size_t)(64u << 20) + (size_t)which * (48u << 20); const float sc = which == 0 ? QK_C2 : 1.0f;
#pragma unroll
            for (int bj = 0; bj < 2; ++bj) { const int cg = half * 256 + bj * HALF + wc * 32 + 8 * fq, h = cg >> 6, dd = cg & 63;
#pragma unroll
                for (int ai = 0; ai < 2; ++ai)
#pragma unroll
                    for (int m = 0; m < 4; ++m) { const int row = row0 + ai * HALF + m * 16, b = row >> 13, t = row & 8191, r = t & ((1 << dlog) - 1), l = t >> dlog;
                        const size_t hr = (size_t)(((g * 4 + b) * 8 + h) * 8192 + r * (8192 >> dlog) + l);
                        const f32x4 v0 = acc[ai][bj][m][0] * sc, v1 = acc[ai][bj][m][1] * sc;
                        u32x4 w; w.x = cvt_pk_bf16(v0[0], v0[1]); w.y = cvt_pk_bf16(v0[2], v0[3]); w.z = cvt_pk_bf16(v1[0], v1[1]); w.w = cvt_pk_bf16(v1[2], v1[3]);
                        *(u32x4*)(base + hr * 64 + dd) = w; } }
        }
    }
};

struct EpiGate {
    static constexpr bool PERM = true, AFTER_DRAIN = false; static constexpr int HOOK_T = -1;
    bf16_t* SG;
    __device__ __forceinline__ void hook(f32x4 (&)[2][2][4][2], const Unit&, int, int, int, int) const {}
    __device__ __forceinline__ void operator()(const f32x4 (&acc)[2][2][4][2], const Unit& u, int wr, int wc, int fr, int fq) const {
        asm volatile("" : "+v"(fr), "+v"(fq));
        const int row0 = u.pm * BM + wr * 64 + fr, j0 = u.pn * HALF + wc * 32 + 8 * fq;
#pragma unroll
        for (int ai = 0; ai < 2; ++ai)
#pragma unroll
            for (int m = 0; m < 4; ++m) { bf16_t* rowp = SG + (size_t)(row0 + ai * HALF + m * 16) * 2048 + j0;
                float rr[8], sb[8];
#pragma unroll
                for (int n = 0; n < 2; ++n)
#pragma unroll
                    for (int i = 0; i < 4; ++i) { const float ea = __builtin_amdgcn_exp2f(-1.4426950408889634f * acc[ai][0][m][n][i]), eb = __builtin_amdgcn_exp2f(-1.4426950408889634f * acc[ai][1][m][n][i]);
                        const float s = __builtin_amdgcn_rcpf(1.0f + eb); sb[n * 4 + i] = s; rr[n * 4 + i] = (1.0f + eb) * __builtin_amdgcn_rcpf(1.0f + ea); }
                u32x4 w; w.x = cvt_pk_bf16(rr[0], rr[1]); w.y = cvt_pk_bf16(rr[2], rr[3]); w.z = cvt_pk_bf16(rr[4], rr[5]); w.w = cvt_pk_bf16(rr[6], rr[7]);
                *(u32x4*)(rowp) = w;
                u32x4 x; x.x = cvt_pk_bf16(sb[0], sb[1]); x.y = cvt_pk_bf16(sb[2], sb[3]); x.z = cvt_pk_bf16(sb[4], sb[5]); x.w = cvt_pk_bf16(sb[6], sb[7]);
                *(u32x4*)(rowp + 1024) = x; }
    }
};

struct EpiMerge {
    static constexpr bool PERM = true, AFTER_DRAIN = false; static constexpr int HOOK_T = 16;
    const bf16_t* SG; bf16_t* O;
    __device__ __forceinline__ void hook(f32x4 (&acc)[2][2][4][2], const Unit& u, int wr, int wc, int fr, int fq) const {
        asm volatile("" : "+v"(fr), "+v"(fq));
        const int row0 = u.pm * BM + wr * 64 + fr, col0 = u.pn * BM + wc * 32 + 8 * fq;
#pragma unroll
        for (int ai = 0; ai < 2; ++ai)
#pragma unroll
            for (int m = 0; m < 4; ++m) { const bf16_t* rowp = SG + (size_t)(row0 + ai * HALF + m * 16) * 2048 + col0;
#pragma unroll
                for (int bj = 0; bj < 2; ++bj) { const u32x4 w = *(const u32x4*)(rowp + bj * HALF);
                    acc[ai][bj][m][0] = acc[ai][bj][m][0] * (f32x4){bf_lo(w.x), bf_hi(w.x), bf_lo(w.y), bf_hi(w.y)};
                    acc[ai][bj][m][1] = acc[ai][bj][m][1] * (f32x4){bf_lo(w.z), bf_hi(w.z), bf_lo(w.w), bf_hi(w.w)}; } }
    }
    __device__ __forceinline__ void operator()(const f32x4 (&acc)[2][2][4][2], const Unit& u, int wr, int wc, int fr, int fq) const {
        asm volatile("" : "+v"(fr), "+v"(fq));
        const int row0 = u.pm * BM + wr * 64 + fr, col0 = u.pn * BM + wc * 32 + 8 * fq;
        u32x4 sbv[2][4][2];
#pragma unroll
        for (int ai = 0; ai < 2; ++ai)
#pragma unroll
            for (int m = 0; m < 4; ++m)
#pragma unroll
                for (int bj = 0; bj < 2; ++bj) sbv[ai][m][bj] = *(const u32x4*)(SG + (size_t)(row0 + ai * HALF + m * 16) * 2048 + 1024 + col0 + bj * HALF);
        asm volatile("" ::: "memory");
#pragma unroll
        for (int ai = 0; ai < 2; ++ai)
#pragma unroll
            for (int m = 0; m < 4; ++m) { const size_t row = (size_t)(row0 + ai * HALF + m * 16);
#pragma unroll
                for (int bj = 0; bj < 2; ++bj) { const u32x4 w = sbv[ai][m][bj];
                    const f32x4 v0 = acc[ai][bj][m][0] * (f32x4){bf_lo(w.x), bf_hi(w.x), bf_lo(w.y), bf_hi(w.y)};
                    const f32x4 v1 = acc[ai][bj][m][1] * (f32x4){bf_lo(w.z), bf_hi(w.z), bf_lo(w.w), bf_hi(w.w)};
                    u32x4 o; o.x = cvt_pk_bf16(v0[0], v0[1]); o.y = cvt_pk_bf16(v0[2], v0[3]); o.z = cvt_pk_bf16(v1[0], v1[1]); o.w = cvt_pk_bf16(v1[2], v1[3]);
                    *(u32x4*)(O + row * 1024 + col0 + bj * HALF) = o; } }
    }
};

struct EpiRes {
    static constexpr bool PERM = false, AFTER_DRAIN = false; static constexpr int HOOK_T = -1;
    const float* base; float* out; bf16_t* outb; float* SQ;
    __device__ __forceinline__ void hook(f32x4 (&)[2][2][4][2], const Unit&, int, int, int, int) const {}
    __device__ __forceinline__ void operator()(const f32x4 (&acc)[2][2][4][2], const Unit& u, int wr, int wc, int fr, int fq) const {
        typedef unsigned u32x2v __attribute__((ext_vector_type(2)));
        asm volatile("" : "+v"(fr), "+v"(fq));
        const int row0 = u.pm * BM + wr * 64 + fr, col0 = u.pn * BM + wc * 32 + 4 * fq;
#pragma unroll
        for (int ai = 0; ai < 2; ++ai) {
            f32x4 pre[4][2][2];
#pragma unroll
            for (int m = 0; m < 4; ++m)
#pragma unroll
                for (int bj = 0; bj < 2; ++bj)
#pragma unroll
                    for (int n = 0; n < 2; ++n) pre[m][bj][n] = *(const f32x4*)(base + (size_t)(row0 + ai * HALF + m * 16) * 1024 + col0 + bj * HALF + n * 16);
            asm volatile("" ::: "memory");
#pragma unroll
            for (int m = 0; m < 4; ++m) { const int row = row0 + ai * HALF + m * 16; const size_t off = (size_t)row * 1024 + col0; float ss = 0.f;
#pragma unroll
                for (int bj = 0; bj < 2; ++bj)
#pragma unroll
                    for (int n = 0; n < 2; ++n) { const size_t o2 = off + bj * HALF + n * 16; const f32x4 h = pre[m][bj][n] + acc[ai][bj][m][n];
                        if (out) *(f32x4*)(out + o2) = h; ss += (h[0] * h[0] + h[1] * h[1]) + (h[2] * h[2] + h[3] * h[3]);
                        if (outb) { u32x2v w; w.x = cvt_pk_bf16(h[0], h[1]); w.y = cvt_pk_bf16(h[2], h[3]); *(u32x2v*)(outb + o2) = w; } }
                ss += __shfl_xor(ss, 16); ss += __shfl_xor(ss, 32);
                if (fq == 0) SQ[(size_t)row * 16 + u.pn * 4 + wc] = ss; }
            asm volatile("" ::: "memory");
        }
    }
};

struct EpiSwiglu {
    static constexpr bool PERM = true, AFTER_DRAIN = false; static constexpr int HOOK_T = -1;
    const float* SQ; bf16_t* ACT; float eps;
    __device__ __forceinline__ void hook(f32x4 (&)[2][2][4][2], const Unit&, int, int, int, int) const {}
    __device__ __forceinline__ void operator()(const f32x4 (&acc)[2][2][4][2], const Unit& u, int wr, int wc, int fr, int fq) const {
        asm volatile("" : "+v"(fr), "+v"(fq));
        const int row0 = u.pm * BM + wr * 64 + fr, j0 = u.pn * HALF + wc * 32 + 8 * fq;
        f32x4 p4v[2][4];
#pragma unroll
        for (int ai = 0; ai < 2; ++ai)
#pragma unroll
            for (int m = 0; m < 4; ++m) p4v[ai][m] = *(const f32x4*)(SQ + (size_t)(row0 + ai * HALF + m * 16) * 16 + 4 * fq);
        asm volatile("" ::: "memory");
#pragma unroll
        for (int ai = 0; ai < 2; ++ai)
#pragma unroll
            for (int m = 0; m < 4; ++m) { const int row = row0 + ai * HALF + m * 16;
                const f32x4 p4 = p4v[ai][m]; float ss = (p4[0] + p4[1]) + (p4[2] + p4[3]);
                ss += __shfl_xor(ss, 16); ss += __shfl_xor(ss, 32);
                const float rstd = 1.0f / sqrtf(ss * (1.0f / 1024.0f) + eps);
                float o[8];
#pragma unroll
                for (int n = 0; n < 2; ++n)
#pragma unroll
                    for (int i = 0; i < 4; ++i) { const float gt = acc[ai][0][m][n][i] * rstd, up = acc[ai][1][m][n][i] * rstd; o[n * 4 + i] = gt * sigmoid_f(gt) * up; }
                u32x4 w; w.x = cvt_pk_bf16(o[0], o[1]); w.y = cvt_pk_bf16(o[2], o[3]); w.z = cvt_pk_bf16(o[4], o[5]); w.w = cvt_pk_bf16(o[6], o[7]);
                *(u32x4*)(ACT + (size_t)row * 2816 + j0) = w; }
    }
};

struct GateOrder {
    StaticOrder S1;
    __host__ __device__ void init(int M, int G_, int c_) { S1.init(M, 1024, G_, c_); }
    __host__ __device__ bool next(int i, Unit& u) const { Unit t; if (!S1.next(i >> 1, t)) return false; u.pm = t.pm; u.pn = 2 * t.pn + (i & 1); return true; }
    __device__ __forceinline__ void a_ready(const Unit&) const {}
    __device__ __forceinline__ void done(const Unit&) const {}
};

template <class Epi, class Sched, bool ALIGN_EPI = false, bool SP2 = false>
__device__ __forceinline__ void gemm_phase(PG8_LAS unsigned char* lds, const Gemm g, const Sched& S, const Epi& E) {
    const int tid = threadIdx.x, wid = __builtin_amdgcn_readfirstlane(tid >> 6), lane = tid & 63, wr = wid >> 2, wc = wid & 3, fr = lane & 15, fq = lane >> 4;
    const int K = g.K, nt = K / BK;
    unsigned voffA[2], voffB[2];
#pragma unroll
    for (int i = 0; i < 2; ++i) { int R, C; stage_rc(tid * 16 + i * 8192, R, C); const int Rb = Epi::PERM ? ((R & ~31) + perm32(R & 31)) : R;
        voffA[i] = (unsigned)(R * K + C) * 2u; voffB[i] = (unsigned)(Rb * K + C) * 2u; }
    const size_t kstep = (size_t)(BK * 2);
    const size_t hstep = (size_t)HALF * K * 2;
    const size_t tstep = 2 * hstep;
    const unsigned ldsw = (unsigned)wid * 1024u;
    const int aoff = lds_byte(wr * 64 + fr, fq * 8), boff = lds_byte(wc * 32 + fr, fq * 8);
#define PG8_SA(b, h) (((b) * 2 + (h)) * HTB)
#define PG8_SB(b, h) ((4 + (b) * 2 + (h)) * HTB)
#define PG8_STAGE(bufoff, gbase, voff) do { _Pragma("unroll") for (int _i = 0; _i < 2; ++_i) \
        __builtin_amdgcn_global_load_lds((const unsigned*)((const char*)(gbase) + (voff)[_i]), (PG8_LAS unsigned*)(lds + (bufoff) + ldsw + _i * 8192), 16, 0, 0); } while (0)
#define PG8_LDA(dst, b, h) do { _Pragma("unroll") for (int m = 0; m < 4; ++m) _Pragma("unroll") for (int k = 0; k < 2; ++k) dst[m][k] = *(const PG8_LAS bf16x8*)(lds + PG8_SA(b, h) + aoff + m * 2048 + k * 1024); } while (0)
#define PG8_LDB(dst, b, h) do { _Pragma("unroll") for (int n = 0; n < 2; ++n) _Pragma("unroll") for (int k = 0; k < 2; ++k) dst[n][k] = *(const PG8_LAS bf16x8*)(lds + PG8_SB(b, h) + boff + n * 2048 + k * 1024); } while (0)
#define PG8_MMA(ai, bj, At, Bt) do { __builtin_amdgcn_s_setprio(1); _Pragma("unroll") for (int m = 0; m < 4; ++m) _Pragma("unroll") for (int n = 0; n < 2; ++n) _Pragma("unroll") for (int k = 0; k < 2; ++k) \
        acc[ai][bj][m][n] = __builtin_amdgcn_mfma_f32_16x16x32_bf16(Bt[n][k], At[m][k], acc[ai][bj][m][n], 0, 0, 0); __builtin_amdgcn_s_setprio(0); } while (0)
#define PG8_WAIT_V(n) asm volatile("s_waitcnt vmcnt(" #n ")" ::: "memory")
#define PG8_WAIT_L(n) asm volatile("s_waitcnt lgkmcnt(" #n ")" ::: "memory")
#define PG8_BAR __builtin_amdgcn_s_barrier()
#define PG8_SCHED __builtin_amdgcn_sched_barrier(0)
    Unit cur, nxt; int ui = 0;
    if (!S.next(0, cur)) return;
    f32x4 acc[2][2][4][2];
#pragma unroll
    for (int a = 0; a < 2; ++a)
#pragma unroll
        for (int b = 0; b < 2; ++b)
#pragma unroll
            for (int m = 0; m < 4; ++m)
#pragma unroll
                for (int n = 0; n < 2; ++n) acc[a][b][m][n] = (f32x4){0.f, 0.f, 0.f, 0.f};
    bf16x8 At[4][2], B0[2][2], B1[2][2];
    const char* cA = (const char*)g.A + (size_t)cur.pm * tstep; const char* cB = (const char*)g.Bt + (size_t)cur.pn * tstep;
    S.a_ready(cur);
    if constexpr (SP2) {
        PG8_STAGE(PG8_SB(0, 0), cB, voffB); PG8_STAGE(PG8_SB(0, 1), cB + hstep, voffB); PG8_STAGE(PG8_SA(0, 0), cA, voffA); PG8_STAGE(PG8_SA(0, 1), cA + hstep, voffA);
        if (wr == 1) PG8_BAR;
        PG8_WAIT_V(2); PG8_BAR;
        PG8_STAGE(PG8_SB(1, 0), cB + kstep, voffB); PG8_STAGE(PG8_SA(1, 0), cA + kstep, voffA); PG8_STAGE(PG8_SB(1, 1), cB + hstep + kstep, voffB);
        PG8_WAIT_V(6); PG8_BAR;
    } else {
        PG8_STAGE(PG8_SB(0, 0), cB, voffB); PG8_STAGE(PG8_SA(0, 0), cA, voffA); PG8_STAGE(PG8_SB(0, 1), cB + hstep, voffB); PG8_STAGE(PG8_SA(0, 1), cA + hstep, voffA);
        if (wr == 1) PG8_BAR;
        PG8_WAIT_V(4); PG8_BAR;
        PG8_STAGE(PG8_SB(1, 0), cB + kstep, voffB); PG8_STAGE(PG8_SA(1, 0), cA + kstep, voffA); PG8_STAGE(PG8_SB(1, 1), cB + hstep + kstep, voffB);
        PG8_WAIT_V(6); PG8_BAR;
    }
    for (;;) {
        const bool has_next = S.next(ui + 1, nxt);
        const char* nA = has_next ? (const char*)g.A + (size_t)nxt.pm * tstep : cA; const char* nB = has_next ? (const char*)g.Bt + (size_t)nxt.pn * tstep : cB;
        for (int t = 0; t < nt; t += 2) {
            if constexpr (Epi::HOOK_T >= 0) { if (t == Epi::HOOK_T) E.hook(acc, cur, wr, wc, fr, fq); }
            const bool last = (t == nt - 2);
            const char* a1 = cA + (size_t)(t + 1) * kstep;
            const char* a2 = last ? nA : cA + (size_t)(t + 2) * kstep; const char* b2 = last ? nB : cB + (size_t)(t + 2) * kstep;
            const char* a3 = a2 + kstep; const char* b3 = b2 + kstep;
            if (last && has_next) S.a_ready(nxt);
            if constexpr (SP2) {
            PG8_LDB(B0, 0, 0); PG8_LDB(B1, 0, 1); PG8_SCHED; PG8_LDA(At, 0, 0); PG8_STAGE(PG8_SA(1, 1), a1 + hstep, voffA);
            PG8_WAIT_V(8); PG8_WAIT_L(0); PG8_BAR; PG8_MMA(0, 0, At, B0); PG8_MMA(0, 1, At, B1); PG8_BAR; PG8_SCHED;
            PG8_LDA(At, 0, 1); PG8_STAGE(PG8_SB(0, 0), b2, voffB); PG8_STAGE(PG8_SB(0, 1), b2 + hstep, voffB); PG8_STAGE(PG8_SA(0, 0), a2, voffA);
            PG8_WAIT_V(8); PG8_WAIT_L(0); PG8_BAR; PG8_MMA(1, 0, At, B0); PG8_MMA(1, 1, At, B1); PG8_BAR; PG8_SCHED;
            PG8_LDB(B0, 1, 0); PG8_LDB(B1, 1, 1); PG8_SCHED; PG8_LDA(At, 1, 0); PG8_STAGE(PG8_SA(0, 1), a2 + hstep, voffA);
            PG8_WAIT_V(8); PG8_WAIT_L(0); PG8_BAR; PG8_MMA(0, 0, At, B0); PG8_MMA(0, 1, At, B1); PG8_BAR; PG8_SCHED;
            PG8_LDA(At, 1, 1); PG8_STAGE(PG8_SB(1, 0), b3, voffB); PG8_STAGE(PG8_SB(1, 1), b3 + hstep, voffB); PG8_STAGE(PG8_SA(1, 0), a3, voffA);
            PG8_WAIT_V(8); PG8_WAIT_L(0); PG8_BAR; PG8_MMA(1, 0, At, B0); PG8_MMA(1, 1, At, B1); PG8_BAR; PG8_SCHED;
            } else {
            PG8_LDB(B0, 0, 0); PG8_SCHED; PG8_LDA(At, 0, 0); PG8_STAGE(PG8_SA(1, 1), a1 + hstep, voffA);
            PG8_WAIT_L(8); PG8_BAR; PG8_WAIT_L(0); PG8_MMA(0, 0, At, B0); PG8_BAR; PG8_SCHED;
            PG8_LDB(B1, 0, 1); PG8_STAGE(PG8_SB(0, 0), b2, voffB);
            PG8_BAR; PG8_WAIT_L(0); PG8_MMA(0, 1, At, B1); PG8_BAR;
            PG8_LDA(At, 0, 1); PG8_STAGE(PG8_SA(0, 0), a2, voffA);
            PG8_BAR; PG8_WAIT_L(0); PG8_MMA(1, 0, At, B0); PG8_BAR; PG8_SCHED;
            PG8_STAGE(PG8_SB(0, 1), b2 + hstep, voffB);
            PG8_WAIT_V(6); PG8_BAR; PG8_MMA(1, 1, At, B1); PG8_BAR;
            PG8_LDB(B0, 1, 0); PG8_SCHED; PG8_LDA(At, 1, 0); PG8_STAGE(PG8_SA(0, 1), a2 + hstep, voffA);
            PG8_WAIT_L(8); PG8_BAR; PG8_WAIT_L(0); PG8_MMA(0, 0, At, B0); PG8_BAR; PG8_SCHED;
            PG8_LDB(B1, 1, 1); PG8_STAGE(PG8_SB(1, 0), b3, voffB);
            PG8_BAR; PG8_WAIT_L(0); PG8_MMA(0, 1, At, B1); PG8_BAR;
            PG8_LDA(At, 1, 1); PG8_STAGE(PG8_SA(1, 0), a3, voffA);
            PG8_BAR; PG8_WAIT_L(0); PG8_MMA(1, 0, At, B0); PG8_BAR; PG8_SCHED;
            PG8_STAGE(PG8_SB(1, 1), b3 + hstep, voffB);
            PG8_WAIT_V(6); PG8_BAR; PG8_MMA(1, 1, At, B1); PG8_BAR;
            }
        }
        if constexpr (ALIGN_EPI) { if (wr == 0) PG8_BAR; }
        if constexpr (!Epi::AFTER_DRAIN) { E(acc, cur, wr, wc, fr, fq); S.done(cur); }
        if (!has_next) break;
#pragma unroll
        for (int a = 0; a < 2; ++a)
#pragma unroll
            for (int b = 0; b < 2; ++b)
#pragma unroll
                for (int m = 0; m < 4; ++m)
#pragma unroll
                    for (int n = 0; n < 2; ++n) acc[a][b][m][n] = (f32x4){0.f, 0.f, 0.f, 0.f};
        cur = nxt; cA = nA; cB = nB; ++ui;
        if constexpr (ALIGN_EPI) { if (wr == 1) PG8_BAR; }
    }
    PG8_WAIT_V(0);
    if constexpr (!ALIGN_EPI) { if (wr == 0) PG8_BAR; }
    PG8_BAR;
    if constexpr (Epi::AFTER_DRAIN) { E.fused(acc, cur, wr, wc, fr, fq, lds, wid, lane); S.done(cur); }
#undef PG8_SA
#undef PG8_SB
#undef PG8_STAGE
#undef PG8_LDA
#undef PG8_LDB
#undef PG8_MMA
#undef PG8_WAIT_V
#undef PG8_WAIT_L
#undef PG8_BAR
#undef PG8_SCHED
}
}

#define GAS __attribute__((address_space(1)))
#define LAS __attribute__((address_space(3)))
typedef unsigned short bf16;
typedef unsigned v4u __attribute__((ext_vector_type(4)));
typedef float f32x4 __attribute__((ext_vector_type(4)));
typedef short bf16x8 __attribute__((ext_vector_type(8)));
typedef GAS unsigned gu32;
typedef GAS unsigned long long gu64;
#define RLX_AGENT __ATOMIC_RELAXED, __HIP_MEMORY_SCOPE_AGENT
#define LDS_WAIT() asm volatile("s_waitcnt lgkmcnt(0)" ::: "memory")
#define VM_WAIT() asm volatile("s_waitcnt vmcnt(0)" ::: "memory")
__device__ __forceinline__ unsigned long long rt() { return __builtin_amdgcn_s_memrealtime(); }
__device__ __forceinline__ unsigned f2bf(float f) { unsigned u = __builtin_bit_cast(unsigned, f); return (u + 0x7fffu + ((u >> 16) & 1u)) >> 16; }
__device__ __forceinline__ unsigned pk2(float lo, float hi) { return f2bf(lo) | (f2bf(hi) << 16); }

#define XB_TMO      128
#define XB_XCNT(j)  (256  + 64 * (j))
#define XB_XSUB(j)  (1280 + 64 * (j))
#define XB_XGEN(j)  (2304 + 64 * (j))
#define XB_TOP      3328
#define XB_TOPGEN   3392
#define XCD_BAR_WORDS 3456
#define XB_SPIN_CAP (1u << 18)

__device__ __forceinline__ unsigned xb_ld(unsigned* p)              { return __hip_atomic_load(p, __ATOMIC_RELAXED, __HIP_MEMORY_SCOPE_AGENT); }
__device__ __forceinline__ unsigned xb_add(unsigned* p, unsigned v) { return __hip_atomic_fetch_add(p, v, __ATOMIC_RELAXED, __HIP_MEMORY_SCOPE_AGENT); }
__device__ __forceinline__ unsigned xb_xcc_id() { return (unsigned)__builtin_amdgcn_s_getreg((3 << 11) | 20) & 0xFu; }
#define XB_SPIN(cond, bar) do { unsigned _sp = 0; while (cond) { __builtin_amdgcn_s_sleep(1); \
    if ((++_sp & 255u) == 0u) { if (xb_ld(&(bar)[XB_TMO])) break; if (_sp > XB_SPIN_CAP) { atomicAdd(&(bar)[XB_TMO], 1u); break; } } } } while (0)

struct XcdBarrier {
    unsigned* bar; unsigned x;
    volatile LAS unsigned* st;
};

__device__ __forceinline__ XcdBarrier xcd_barrier_post(unsigned* bar, volatile LAS unsigned* st) {
    XcdBarrier b; b.bar = bar; b.x = xb_xcc_id(); b.st = st;
    if (threadIdx.x == 0) (void)xb_add(&bar[XB_XCNT(b.x)], 1u);
    return b;
}
__device__ __forceinline__ void xcd_barrier_complete(unsigned* bar, unsigned x, unsigned& nloc, unsigned& nx) {
    const unsigned G = gridDim.x * gridDim.y * gridDim.z;
    unsigned sum, cnt, mine, sp = 0u;
    for (;;) {
        sum = 0u; cnt = 0u; mine = 0u;
#pragma unroll
        for (unsigned j = 0; j < 16; ++j) { const unsigned c = xb_ld(&bar[XB_XCNT(j)]); sum += c; cnt += (c > 0u) ? 1u : 0u; mine = (j == x) ? c : mine; }
        if (sum == G) break;
        __builtin_amdgcn_s_sleep(1);
        if ((++sp & 255u) == 0u) { if (xb_ld(&bar[XB_TMO])) break; if (sp > XB_SPIN_CAP) { atomicAdd(&bar[XB_TMO], 1u); break; } }
    }
    nloc = mine > 0u ? mine : 1u; nx = cnt > 0u ? cnt : 1u;
}

__device__ __forceinline__ void xcd_barrier(const XcdBarrier& b) {
    asm volatile("s_waitcnt vmcnt(0)" ::: "memory");
    __syncthreads();
    if (threadIdx.x == 0) {
        unsigned* bar = b.bar;
        __builtin_amdgcn_s_waitcnt(0);
        unsigned nloc = b.st[0], nx = b.st[1];
        if (nloc == 0u) { xcd_barrier_complete(bar, b.x, nloc, nx); b.st[0] = nloc; b.st[1] = nx; }
        const unsigned old = xb_add(&bar[XB_XSUB(b.x)], 1u);
        const unsigned gen = old / nloc;
        if (old + 1u == (gen + 1u) * nloc) {
            __builtin_amdgcn_fence(__ATOMIC_RELEASE, "agent");
            asm volatile("s_waitcnt vmcnt(0)" ::: "memory");
            const unsigned og = xb_add(&bar[XB_TOP], 1u);
            const unsigned tg = og / nx;
            if (og + 1u == (tg + 1u) * nx) xb_add(&bar[XB_TOPGEN], 1u);
            else XB_SPIN(xb_ld(&bar[XB_TOPGEN]) == tg, bar);
            __builtin_amdgcn_fence(__ATOMIC_ACQUIRE, "agent");
            xb_add(&bar[XB_XGEN(b.x)], 1u);
            asm volatile("s_waitcnt vmcnt(0)" ::: "memory");
        } else {
            XB_SPIN(xb_ld(&bar[XB_XGEN(b.x)]) == gen, bar);
            __builtin_amdgcn_fence(__ATOMIC_ACQUIRE, "agent");
            asm volatile("s_waitcnt vmcnt(0)" ::: "memory");
        }
    }
    __syncthreads();
}


constexpr int NWAVES = 8;
#ifndef MK_N_LAUNCHES
#define MK_N_LAUNCHES 1
#endif
#ifndef REP_P0
#define REP_P0 1
#endif
#ifndef REP_P1
#define REP_P1 1
#endif
#ifndef REP_P2B
#define REP_P2B 1
#endif
#ifndef REP_P3
#define REP_P3 1
#endif
#ifndef REP_P4
#define REP_P4 1
#endif
#ifndef REP_P5
#define REP_P5 1
#endif
constexpr int PER_PHASE = 9;
constexpr int N_LAUNCHES = MK_N_LAUNCHES;

constexpr int BATCH = 4, SEQ = 8192, D = 1024, M = BATCH * SEQ, NP1 = 6656, NGATE = 2048, FF = 2816, FF2 = 5632, KCAT = 1536;
constexpr float NORM_EPS = 1e-6f;
constexpr int NHR = 3 * BATCH * 8 * SEQ;

constexpr size_t MiB = 1u << 20;
constexpr size_t WS_CTL = 0, CTL_ZERO_BYTES = 1 * MiB;
constexpr size_t WS_WIN = 2 * MiB;
constexpr size_t WS_WAB = 19 * MiB;
constexpr size_t WS_WOUT = 22 * MiB;
constexpr size_t WS_WGU = 24 * MiB;
constexpr size_t WS_WDN = 35 * MiB;
constexpr size_t WS_GWS = 41 * MiB;
constexpr size_t WS_SQ1 = 42 * MiB;
constexpr size_t WS_SQ2 = 44 * MiB;
constexpr size_t WS_LSE = 46 * MiB;
constexpr size_t WS_R = 50 * MiB;
constexpr size_t WS_U = WS_R, WS_VG = WS_R + 64 * MiB, WS_Q = WS_R + 128 * MiB, WS_K = WS_R + 224 * MiB, WS_V = WS_R + 320 * MiB;
constexpr size_t WS_YCAT = WS_K;
constexpr size_t WS_SG = WS_R;
constexpr size_t WS_MRG = WS_V;
constexpr size_t WS_H1B = WS_K;
constexpr size_t WS_ACT = WS_R;
constexpr size_t WS_END = WS_R + 416 * MiB;

constexpr int RING_OFF = 0, RING_BYTES = 131072;
constexpr int LDSCTL_OFF = RING_BYTES, MISC_OFF = LDSCTL_OFF + 320;
constexpr int LDS_BYTES = 147456;
constexpr int CW_BAR = 4096;

struct Args { const float* in[15]; float* out; unsigned char* ws; int ph_lo, ph_hi; };

struct Frame {
    LAS unsigned char* lds;
    volatile LAS unsigned* MISC;
    gu32* ctl;
    int tid, lane, wave, vcu, G;
};

__device__ __forceinline__ float wave_sum(float v) {
#pragma unroll
    for (int o = 1; o < 64; o <<= 1) v += __shfl_xor(v, o);
    return v;
}
__device__ __forceinline__ float wave_max(float v) {
#pragma unroll
    for (int o = 1; o < 64; o <<= 1) v = fmaxf(v, __shfl_xor(v, o));
    return v;
}
__device__ __forceinline__ float bf2f(unsigned short h) { return __uint_as_float((unsigned)h << 16); }

__device__ __forceinline__ void p0_transpose_item(const float* W, int K, int N, int ncol0, bf16* WT, int ldk, int k_off, int mode, int row_off, const float* kscale, LAS float* scr, int item, int nblk, int lane) {
    const int kb = item / nblk, nb = item % nblk, k0 = 64 * kb, n0 = 32 * nb;
#pragma unroll 8
    for (int i = 0; i < 32; ++i) { const int kk = 2 * i + (lane >> 5); float v = W[(size_t)(k0 + kk) * N + ncol0 + n0 + (lane & 31)]; if (kscale) v *= kscale[k0 + kk]; scr[kk * 33 + (lane & 31)] = v; }
    LDS_WAIT(); asm volatile("" ::: "memory");
    const int c = lane & 7; const int drow0 = mode == 0 ? row_off + n0 : ((n0 >> 7) << 8) + (n0 & 127) + row_off;
#pragma unroll
    for (int j = 0; j < 4; ++j) { const int n = (lane >> 3) + 8 * j; const LAS float* s = scr + (8 * c) * 33 + n;
        v4u o; o.x = pk2(s[0 * 33], s[1 * 33]); o.y = pk2(s[2 * 33], s[3 * 33]); o.z = pk2(s[4 * 33], s[5 * 33]); o.w = pk2(s[6 * 33], s[7 * 33]);
        *(GAS v4u*)(WT + (size_t)(drow0 + n) * ldk + k_off + k0 + 8 * c) = o; }
    LDS_WAIT(); asm volatile("" ::: "memory");
}
__device__ __forceinline__ void p0_prologue(Frame& F, const Args& a) {
    unsigned char* ws = a.ws;
    LAS float* scr = (LAS float*)(F.lds + RING_OFF + F.wave * 16384);
    const int gw = F.vcu * NWAVES + F.wave, NGW = F.G * NWAVES;
    constexpr int I_P1 = 16 * (NP1 / 32), I_G = 16 * (1024 / 32), I_A = 16 * 32, I_B = 8 * 32, I_O = 16 * 32, I_F = 16 * (FF / 32), I_D = (FF / 64) * 32;
    constexpr int NITEMS = I_P1 + 2 * I_G + I_A + I_B + I_O + 2 * I_F + I_D;
    const float* w_in = a.in[2];
    for (int it = gw; it < NITEMS; it += NGW) {
        int r = it;
        if (r < I_P1) { p0_transpose_item(w_in, D, 8704, 0, (bf16*)(ws + WS_WIN), D, 0, 0, 0, nullptr, scr, r, NP1 / 32, F.lane); continue; } r -= I_P1;
        if (r < I_G) { p0_transpose_item(w_in, D, 8704, 6656, (bf16*)(ws + WS_WIN), D, 0, 1, 6656, nullptr, scr, r, 32, F.lane); continue; } r -= I_G;
        if (r < I_G) { p0_transpose_item(w_in, D, 8704, 7680, (bf16*)(ws + WS_WIN), D, 0, 1, 6656 + 128, nullptr, scr, r, 32, F.lane); continue; } r -= I_G;
        if (r < I_A) { p0_transpose_item(a.in[7], 1024, 1024, 0, (bf16*)(ws + WS_WAB), KCAT, 0, 0, 0, nullptr, scr, r, 32, F.lane); continue; } r -= I_A;
        if (r < I_B) { p0_transpose_item(a.in[8], 512, 1024, 0, (bf16*)(ws + WS_WAB), KCAT, 1024, 0, 0, nullptr, scr, r, 32, F.lane); continue; } r -= I_B;
        if (r < I_O) { p0_transpose_item(a.in[9], 1024, 1024, 0, (bf16*)(ws + WS_WOUT), D, 0, 0, 0, nullptr, scr, r, 32, F.lane); continue; } r -= I_O;
        if (r < I_F) { p0_transpose_item(a.in[11], D, FF, 0, (bf16*)(ws + WS_WGU), D, 0, 1, 0, a.in[10], scr, r, FF / 32, F.lane); continue; } r -= I_F;
        if (r < I_F) { p0_transpose_item(a.in[12], D, FF, 0, (bf16*)(ws + WS_WGU), D, 0, 1, 128, a.in[10], scr, r, FF / 32, F.lane); continue; } r -= I_F;
        p0_transpose_item(a.in[13], FF, D, 0, (bf16*)(ws + WS_WDN), FF, 0, 0, 0, nullptr, scr, r, 32, F.lane);
    }
    { const float* gws = a.in[5]; bf16* o = (bf16*)(ws + WS_GWS); const int gt = F.vcu * (NWAVES * 64) + F.tid, NT = F.G * NWAVES * 64;
      for (int i = gt; i < 8 * 128 * 128 / 2; i += NT) ((GAS unsigned*)o)[i] = pk2(gws[2 * i], gws[2 * i + 1]); }
    { const float* x = a.in[0]; const float* g = a.in[1]; bf16* XN = (bf16*)a.out;
      f32x4 gv[4];
#pragma unroll
      for (int j = 0; j < 4; ++j) gv[j] = *((const GAS f32x4*)g + F.lane + 64 * j);
      for (int m = gw; m < M; m += NGW) {
        const GAS f32x4* xr = (const GAS f32x4*)(x + (size_t)m * D) + F.lane; f32x4 v[4]; float s = 0.f;
#pragma unroll
        for (int j = 0; j < 4; ++j) { v[j] = xr[64 * j]; s += (v[j].x * v[j].x + v[j].y * v[j].y) + (v[j].z * v[j].z + v[j].w * v[j].w); }
        const float rstd = 1.f / sqrtf(wave_sum(s) * (1.f / D) + NORM_EPS);
        GAS unsigned long long* o8 = (GAS unsigned long long*)(XN + (size_t)m * D) + F.lane;
#pragma unroll
        for (int j = 0; j < 4; ++j) o8[64 * j] = (unsigned long long)pk2(v[j].x * rstd * gv[j].x, v[j].y * rstd * gv[j].y) | ((unsigned long long)pk2(v[j].z * rstd * gv[j].z, v[j].w * rstd * gv[j].w) << 32);
      } }
}

__device__ __forceinline__ void attn_simple(Frame& F, bf16* Qb, const bf16* Kb, const bf16* Vb, float* LSE) {
    const int gw = F.vcu * NWAVES + F.wave, NGW = F.G * NWAVES, lane = F.lane;
    for (int R = gw; R < NHR; R += NGW) {
        const int g = R >> 18, rem = R & 262143, b = rem >> 16, h = (rem >> 13) & 7, p = rem & 8191;
        const int dlog = 2 * g, L = 8192 >> dlog, l = p & (L - 1), r = p >> (13 - dlog);
        const int seq0 = R - l;
        const float slope2 = __builtin_amdgcn_exp2f(-(float)(g * 8 + h + 1) * (1.0f / 3.0f)) * (float)(1 << dlog) * 1.4426950408889634f;
        float q[64];
        { const GAS v4u* qp = (const GAS v4u*)(Qb + (size_t)R * 64);
#pragma unroll
          for (int c = 0; c < 8; ++c) { const v4u w = qp[c];
            q[8 * c + 0] = __uint_as_float(w.x << 16); q[8 * c + 1] = __uint_as_float(w.x & 0xffff0000u); q[8 * c + 2] = __uint_as_float(w.y << 16); q[8 * c + 3] = __uint_as_float(w.y & 0xffff0000u);
            q[8 * c + 4] = __uint_as_float(w.z << 16); q[8 * c + 5] = __uint_as_float(w.z & 0xffff0000u); q[8 * c + 6] = __uint_as_float(w.w << 16); q[8 * c + 7] = __uint_as_float(w.w & 0xffff0000u); } }
        float s[3]; bool ok[3];
#pragma unroll
        for (int ps = 0; ps < 3; ++ps) {
            const int j = lane + 64 * ps - 64, kl = l + j; ok[ps] = (j <= 64) && (kl >= 0) && (kl < L);
            const int klc = kl < 0 ? 0 : (kl > L - 1 ? L - 1 : kl);
            const GAS v4u* kp = (const GAS v4u*)(Kb + (size_t)(seq0 + klc) * 64); float acc = 0.f;
#pragma unroll
            for (int c = 0; c < 8; ++c) { const v4u w = kp[c];
                acc += q[8 * c + 0] * __uint_as_float(w.x << 16) + q[8 * c + 1] * __uint_as_float(w.x & 0xffff0000u) + q[8 * c + 2] * __uint_as_float(w.y << 16) + q[8 * c + 3] * __uint_as_float(w.y & 0xffff0000u)
                     + q[8 * c + 4] * __uint_as_float(w.z << 16) + q[8 * c + 5] * __uint_as_float(w.z & 0xffff0000u) + q[8 * c + 6] * __uint_as_float(w.w << 16) + q[8 * c + 7] * __uint_as_float(w.w & 0xffff0000u); }
            const float aj = (float)(j < 0 ? -j : j);
            s[ps] = ok[ps] ? acc - slope2 * aj : -1e30f;
        }
        const float mx = wave_max(fmaxf(fmaxf(s[0], s[1]), s[2]));
        float pr[3]; float ls = 0.f;
#pragma unroll
        for (int ps = 0; ps < 3; ++ps) { pr[ps] = ok[ps] ? __builtin_amdgcn_exp2f(s[ps] - mx) : 0.f; ls += pr[ps]; }
        ls = wave_sum(ls);
        float o = 0.f;
#pragma unroll
        for (int ps = 0; ps < 3; ++ps) {
            const int nj = ps == 2 ? 1 : 64;
            for (int jj = 0; jj < nj; ++jj) {
                const float pj = __uint_as_float((unsigned)__builtin_amdgcn_readlane((int)__float_as_uint(pr[ps]), jj));
                int kl = l + jj + 64 * ps - 64; kl = kl < 0 ? 0 : (kl > L - 1 ? L - 1 : kl);
                o += pj * bf2f(Vb[(size_t)(seq0 + kl) * 64 + lane]);
            }
        }
        o = o / ls;
        Qb[(size_t)R * 64 + lane] = (bf16)f2bf(o);
        if (lane == 0) { const int token = b * SEQ + (l << dlog) + r; LSE[((size_t)g * M + token) * 8 + h] = mx + __builtin_amdgcn_logf(ls); }
    }
}

namespace att {
typedef short bf16x8 __attribute__((ext_vector_type(8)));
typedef short s16x4 __attribute__((ext_vector_type(4)));
typedef float f32x16 __attribute__((ext_vector_type(16)));
typedef unsigned u32x2 __attribute__((ext_vector_type(2)));
typedef __attribute__((address_space(3))) const unsigned char* lds_cptr;
constexpr int IMG_ROWS = 384, LDS_K = 0, LDS_V = IMG_ROWS * 128;
__device__ __forceinline__ int sw(int row) { return (((row >> 1) & 1) << 2) | (((row >> 2) & 1) << 1) | ((row >> 3) & 1); }
__device__ __forceinline__ void glds16(const void* gsrc, unsigned lds_dst) { unsigned keep;
    asm volatile("s_mov_b32 %0, m0\n\ts_mov_b32 m0, %2\n\ts_nop 0\n\tglobal_load_lds_dwordx4 %1, off\n\ts_mov_b32 m0, %0" : "=&s"(keep) : "v"(gsrc), "s"(lds_dst) : "memory"); }
__device__ __forceinline__ s16x4 vtr(lds_cptr p) { typedef short v4i16_t __attribute__((ext_vector_type(4))); return __builtin_bit_cast(s16x4, __builtin_amdgcn_ds_read_tr16_b64_v4i16((__attribute__((address_space(3))) v4i16_t*)p)); }
__device__ __forceinline__ unsigned cvtpk(float lo, float hi) { typedef float f2 __attribute__((ext_vector_type(2))); typedef __bf16 b2 __attribute__((ext_vector_type(2))); f2 v = {lo, hi}; b2 b = __builtin_convertvector(v, b2); return __builtin_bit_cast(unsigned, b); }

__device__ __forceinline__ void attn_phase(LAS unsigned char* lds, int vcu, int G, unsigned short* Qb, const unsigned short* Kb, const unsigned short* Vb, float* LSE) {
    int tid_ = threadIdx.x; asm volatile("" : "+v"(tid_));
    const int lane = tid_ & 63, w = __builtin_amdgcn_readfirstlane(tid_ >> 6), ql = lane & 31, hi = lane >> 5;
    const unsigned lds0 = (unsigned)(uintptr_t)lds;
    const lds_cptr L3 = (lds_cptr)lds;
    const int swl = sw(ql);
    int koff[4];
#pragma unroll
    for (int d0 = 0; d0 < 4; ++d0) koff[d0] = LDS_K + (32 * w + ql) * 128 + (((2 * d0 + hi) ^ swl) << 4);
    const int p_ = lane & 3, qrow = (lane & 15) >> 2, gi = (lane >> 4) & 1;
    const int sw0 = ((qrow >> 1) << 2) | (hi << 1);
    int voff[2][2];
#pragma unroll
    for (int dh = 0; dh < 2; ++dh)
#pragma unroll
        for (int sec = 0; sec < 2; ++sec) voff[dh][sec] = LDS_V + (32 * w + 4 * hi + qrow + 8 * sec) * 128 + (((4 * dh + 2 * gi + (p_ >> 1)) ^ (sw0 | sec)) << 4) + (p_ & 1) * 8;
    const float fbase = (float)(4 * hi - ql - 64);
    constexpr int NUNITS = 3 * 4 * 8 * 8192 / 256;
    for (int U = vcu; U < NUNITS; U += G) {
        const int R0 = U * 256, g = R0 >> 18, rem = R0 & 262143, b = rem >> 16, h = (rem >> 13) & 7, p0 = rem & 8191;
        const int dlog = 2 * g, L = 8192 >> dlog, l0 = p0 & (L - 1), r = p0 >> (13 - dlog), seq0 = R0 - l0;
        const float slope2 = __builtin_amdgcn_exp2f(-(float)(g * 8 + h + 1) * (1.0f / 3.0f)) * (float)(1 << dlog) * 1.4426950408889634f;
        __syncthreads();
#pragma unroll
        for (int i = 0; i < 6; ++i) { const int pc = w * 6 + i, row = 8 * pc + (lane >> 3); int ls = l0 - 64 + row; ls = ls < 0 ? 0 : (ls > L - 1 ? L - 1 : ls);
            const size_t eo = (size_t)(seq0 + ls) * 64 + (size_t)(((lane & 7) ^ sw(row)) << 3);
            glds16(Kb + eo, (unsigned)__builtin_amdgcn_readfirstlane(lds0 + LDS_K + pc * 1024));
            glds16(Vb + eo, (unsigned)__builtin_amdgcn_readfirstlane(lds0 + LDS_V + pc * 1024)); }
        bf16x8 qr[4];
        { const unsigned short* qp = Qb + (size_t)(R0 + 32 * w + ql) * 64 + 8 * hi;
#pragma unroll
          for (int d0 = 0; d0 < 4; ++d0) qr[d0] = *(const bf16x8*)(qp + 16 * d0); }
        asm volatile("s_waitcnt vmcnt(0)" ::: "memory");
        __syncthreads();
        f32x16 p[5];
#pragma unroll
        for (int t = 0; t < 5; ++t) {
            p[t] = (f32x16){0.f, 0.f, 0.f, 0.f, 0.f, 0.f, 0.f, 0.f, 0.f, 0.f, 0.f, 0.f, 0.f, 0.f, 0.f, 0.f};
#pragma unroll
            for (int d0 = 0; d0 < 4; ++d0) { const bf16x8 kf = *(const __attribute__((address_space(3))) bf16x8*)(L3 + koff[d0] + t * 4096); p[t] = __builtin_amdgcn_mfma_f32_32x32x16_bf16(kf, qr[d0], p[t], 0, 0, 0); }
        }
        const int kv0 = l0 + 32 * w - 64;
        float mx = -INFINITY;
#pragma unroll
        for (int t = 0; t < 5; ++t) {
            const bool tv = (kv0 + 32 * t >= 0) && (kv0 + 32 * t + 31 < L);
#pragma unroll
            for (int r16 = 0; r16 < 16; ++r16) { const float fd = fbase + (float)(32 * t + (r16 & 3) + 8 * (r16 >> 2));
                float s = __builtin_fmaf(-slope2, __builtin_fabsf(fd), p[t][r16]);
                if (t == 0) s = (fd >= -64.0f) ? s : -INFINITY;
                if (t == 4) s = (fd <= 64.0f) ? s : -INFINITY;
                s = tv ? s : -INFINITY;
                p[t][r16] = s; mx = fmaxf(mx, s); }
        }
        mx = fmaxf(mx, __shfl_xor(mx, 32));
        float lsum = 0.f;
#pragma unroll
        for (int t = 0; t < 5; ++t)
#pragma unroll
            for (int r16 = 0; r16 < 16; ++r16) { const float e = __builtin_amdgcn_exp2f(p[t][r16] - mx); p[t][r16] = e; lsum += e; }
        lsum += __shfl_xor(lsum, 32);
        f32x16 o[2];
        o[0] = (f32x16){0.f, 0.f, 0.f, 0.f, 0.f, 0.f, 0.f, 0.f, 0.f, 0.f, 0.f, 0.f, 0.f, 0.f, 0.f, 0.f}; o[1] = o[0];
#pragma unroll
        for (int t = 0; t < 5; ++t)
#pragma unroll
            for (int s2 = 0; s2 < 2; ++s2) {
                typedef unsigned u32x4 __attribute__((ext_vector_type(4)));
                u32x4 pw; pw.x = cvtpk(p[t][8 * s2 + 0], p[t][8 * s2 + 1]); pw.y = cvtpk(p[t][8 * s2 + 2], p[t][8 * s2 + 3]); pw.z = cvtpk(p[t][8 * s2 + 4], p[t][8 * s2 + 5]); pw.w = cvtpk(p[t][8 * s2 + 6], p[t][8 * s2 + 7]);
                const bf16x8 pf = __builtin_bit_cast(bf16x8, pw);
#pragma unroll
                for (int dh = 0; dh < 2; ++dh) { const s16x4 a = vtr(L3 + voff[dh][0] + t * 4096 + s2 * 2048), c = vtr(L3 + voff[dh][1] + t * 4096 + s2 * 2048);
                    const bf16x8 vf = (bf16x8){a[0], a[1], a[2], a[3], c[0], c[1], c[2], c[3]};
                    o[dh] = __builtin_amdgcn_mfma_f32_32x32x16_bf16(vf, pf, o[dh], 0, 0, 0); }
            }
        const float rl = 1.0f / lsum;
        unsigned short* op = Qb + (size_t)(R0 + 32 * w + ql) * 64 + 4 * hi;
#pragma unroll
        for (int dh = 0; dh < 2; ++dh)
#pragma unroll
            for (int k4 = 0; k4 < 4; ++k4) { u32x2 v; v.x = cvtpk(o[dh][4 * k4 + 0] * rl, o[dh][4 * k4 + 1] * rl); v.y = cvtpk(o[dh][4 * k4 + 2] * rl, o[dh][4 * k4 + 3] * rl);
                *(u32x2*)(op + 32 * dh + 8 * k4) = v; }
        if (hi == 0) { const int l = l0 + 32 * w + ql, token = b * 8192 + (l << dlog) + r; LSE[((size_t)g * 32768 + token) * 8 + h] = mx + __builtin_amdgcn_logf(lsum); }
    }
    __syncthreads();
}
}

__device__ __forceinline__ void gmlp_merge_simple(Frame& F, const Args& a) {
    unsigned char* ws = a.ws;
    const bf16* U = (const bf16*)(ws + WS_U); const bf16* VG = (const bf16*)(ws + WS_VG); const bf16* Ob = (const bf16*)(ws + WS_Q); const float* LSE = (const float*)(ws + WS_LSE);
    const bf16* GWS = (const bf16*)(ws + WS_GWS); bf16* YC = (bf16*)(ws + WS_YCAT);
    const float* ln_g = a.in[3]; const float* ln_b = a.in[4]; const float* bs = a.in[6];
    LAS float* st = (LAS float*)(F.lds + RING_BYTES + 1024);
    LAS float* vn = (LAS float*)(F.lds);
    LAS float* wsl = (LAS float*)(F.lds + 65536);
    const int tid = F.tid, lane = F.lane, wave = F.wave;
    for (int ci = F.vcu; ci < M / 128; ci += F.G) {
        const int tok0 = ci * 128;
        for (int i = 0; i < 16; ++i) { const int tk = wave * 16 + i; const GAS v4u* rp = (const GAS v4u*)(VG + (size_t)(tok0 + tk) * 1024);
            float v[16];
#pragma unroll
            for (int j = 0; j < 2; ++j) { const v4u w = rp[lane + 64 * j];
                v[8 * j + 0] = __uint_as_float(w.x << 16); v[8 * j + 1] = __uint_as_float(w.x & 0xffff0000u); v[8 * j + 2] = __uint_as_float(w.y << 16); v[8 * j + 3] = __uint_as_float(w.y & 0xffff0000u);
                v[8 * j + 4] = __uint_as_float(w.z << 16); v[8 * j + 5] = __uint_as_float(w.z & 0xffff0000u); v[8 * j + 6] = __uint_as_float(w.w << 16); v[8 * j + 7] = __uint_as_float(w.w & 0xffff0000u); }
            float s = 0.f;
#pragma unroll
            for (int j = 0; j < 16; ++j) s += v[j];
            const float mean = wave_sum(s) * (1.0f / 1024.0f); float q = 0.f;
#pragma unroll
            for (int j = 0; j < 16; ++j) { const float d = v[j] - mean; q += d * d; }
            const float rstd = 1.0f / sqrtf(wave_sum(q) * (1.0f / 1024.0f) + NORM_EPS);
            if (lane == 0) { st[2 * tk] = mean; st[2 * tk + 1] = rstd; } }
        __syncthreads();
        for (int g = 0; g < 8; ++g) {
#pragma unroll
            for (int i = 0; i < 4; ++i) { const int idx = tid + 512 * i, s = idx >> 4, c8 = (idx & 15) * 8;
                const v4u w = *(const GAS v4u*)(VG + (size_t)(tok0 + s) * 1024 + 128 * g + c8); const float mean = st[2 * s], rstd = st[2 * s + 1];
                const float* lg = ln_g + 128 * g + c8; const float* lb = ln_b + 128 * g + c8; LAS float* d = vn + s * 128 + c8;
                d[0] = (__uint_as_float(w.x << 16) - mean) * rstd * lg[0] + lb[0]; d[1] = (__uint_as_float(w.x & 0xffff0000u) - mean) * rstd * lg[1] + lb[1];
                d[2] = (__uint_as_float(w.y << 16) - mean) * rstd * lg[2] + lb[2]; d[3] = (__uint_as_float(w.y & 0xffff0000u) - mean) * rstd * lg[3] + lb[3];
                d[4] = (__uint_as_float(w.z << 16) - mean) * rstd * lg[4] + lb[4]; d[5] = (__uint_as_float(w.z & 0xffff0000u) - mean) * rstd * lg[5] + lb[5];
                d[6] = (__uint_as_float(w.w << 16) - mean) * rstd * lg[6] + lb[6]; d[7] = (__uint_as_float(w.w & 0xffff0000u) - mean) * rstd * lg[7] + lb[7];
                const v4u x = *(const GAS v4u*)(GWS + (size_t)g * 16384 + (size_t)s * 128 + c8); LAS float* e = wsl + s * 128 + c8;
                e[0] = __uint_as_float(x.x << 16); e[1] = __uint_as_float(x.x & 0xffff0000u); e[2] = __uint_as_float(x.y << 16); e[3] = __uint_as_float(x.y & 0xffff0000u);
                e[4] = __uint_as_float(x.z << 16); e[5] = __uint_as_float(x.z & 0xffff0000u); e[6] = __uint_as_float(x.w << 16); e[7] = __uint_as_float(x.w & 0xffff0000u); }
            __syncthreads();
            const int c = tid & 127, tq = tid >> 7;
            float acc[32];
#pragma unroll
            for (int tt = 0; tt < 32; ++tt) acc[tt] = 0.f;
            for (int s = 0; s < 128; s += 4) {
                const float v0 = vn[(s + 0) * 128 + c], v1 = vn[(s + 1) * 128 + c], v2 = vn[(s + 2) * 128 + c], v3 = vn[(s + 3) * 128 + c];
#pragma unroll
                for (int tt = 0; tt < 32; ++tt) { const f32x4 w4 = *(const LAS f32x4*)(wsl + (32 * tq + tt) * 128 + s); acc[tt] += w4.x * v0 + w4.y * v1 + w4.z * v2 + w4.w * v3; }
            }
#pragma unroll
            for (int tt = 0; tt < 32; ++tt) { const int t = 32 * tq + tt; const size_t tok = (size_t)(tok0 + t);
                const float uu = bf2f(U[tok * 1024 + 128 * g + c]); YC[tok * KCAT + 128 * g + c] = (bf16)f2bf(uu * (acc[tt] + bs[g * 128 + t])); }
            __syncthreads();
        }
        for (int i = 0; i < 128; ++i) { const int idx = tid + 512 * i, tk = idx >> 9, ch = idx & 511, h = ch >> 6, dd = ch & 63; const int token = tok0 + tk, b = token >> 13, t = token & 8191;
            float ls[3], ov[3];
#pragma unroll
            for (int g = 0; g < 3; ++g) { const int dlog = 2 * g, r = t & ((1 << dlog) - 1), l = t >> dlog; const size_t hr = (size_t)(((g * 4 + b) * 8 + h) * 8192 + r * (8192 >> dlog) + l);
                ov[g] = bf2f(Ob[hr * 64 + dd]); ls[g] = LSE[((size_t)g * M + token) * 8 + h]; }
            const float mx = fmaxf(fmaxf(ls[0], ls[1]), ls[2]); const float w0 = __builtin_amdgcn_exp2f(ls[0] - mx), w1 = __builtin_amdgcn_exp2f(ls[1] - mx), w2 = __builtin_amdgcn_exp2f(ls[2] - mx);
            YC[(size_t)token * KCAT + 1024 + ch] = (bf16)f2bf((w0 * ov[0] + w1 * ov[1] + w2 * ov[2]) / (w0 + w1 + w2)); }
        __syncthreads();
    }
}

namespace gm {
typedef short bf16x8 __attribute__((ext_vector_type(8)));
typedef short s16x4 __attribute__((ext_vector_type(4)));
typedef float f32x4 __attribute__((ext_vector_type(4)));
typedef unsigned u32x4 __attribute__((ext_vector_type(4)));
typedef __attribute__((address_space(3))) const unsigned char* lds_cptr;
__device__ __forceinline__ s16x4 vtr(lds_cptr p) { typedef short v4i16_t __attribute__((ext_vector_type(4))); return __builtin_bit_cast(s16x4, __builtin_amdgcn_ds_read_tr16_b64_v4i16((__attribute__((address_space(3))) v4i16_t*)p)); }
__device__ __forceinline__ unsigned cvtpk(float lo, float hi) { typedef float f2 __attribute__((ext_vector_type(2))); typedef __bf16 b2 __attribute__((ext_vector_type(2))); f2 v = {lo, hi}; b2 b = __builtin_convertvector(v, b2); return __builtin_bit_cast(unsigned, b); }
__device__ __forceinline__ float lo16(unsigned w) { return __uint_as_float(w << 16); }
__device__ __forceinline__ float hi16(unsigned w) { return __uint_as_float(w & 0xffff0000u); }

struct GmlpArgs { const unsigned short *U, *VG, *Ob, *GWS; const float *LSE, *ln_g, *ln_b, *bs; unsigned short* YC; };

__device__ __forceinline__ void gmlp_phase(LAS unsigned char* lds, LAS float* st, int vcu, int G, const GmlpArgs& A) {
    int tid_ = threadIdx.x; asm volatile("" : "+v"(tid_));
    const int tid = tid_, lane = tid & 63, w = __builtin_amdgcn_readfirstlane(tid >> 6), fr = lane & 15, fq = lane >> 4;
    const lds_cptr L3 = (lds_cptr)lds;
    const int qq = (lane & 15) >> 2, p_ = lane & 3, f8 = qq | ((fq & 1) << 2);
    const int rbase = (8 * fq + qq) * 256 + 64 * p_ + (f8 << 3);
    for (int ci = vcu; ci < 256; ci += G) {
        const int tok0 = ci * 128;
        for (int i = 0; i < 16; ++i) { const int tk = w * 16 + i; const u32x4* rp = (const u32x4*)(A.VG + (size_t)(tok0 + tk) * 1024);
            float v[16];
#pragma unroll
            for (int j = 0; j < 2; ++j) { const u32x4 x = rp[lane + 64 * j];
                v[8 * j + 0] = lo16(x.x); v[8 * j + 1] = hi16(x.x); v[8 * j + 2] = lo16(x.y); v[8 * j + 3] = hi16(x.y); v[8 * j + 4] = lo16(x.z); v[8 * j + 5] = hi16(x.z); v[8 * j + 6] = lo16(x.w); v[8 * j + 7] = hi16(x.w); }
            float s = 0.f;
#pragma unroll
            for (int j = 0; j < 16; ++j) s += v[j];
#pragma unroll
            for (int o = 1; o < 64; o <<= 1) s += __shfl_xor(s, o);
            const float mean = s * (1.0f / 1024.0f); float q = 0.f;
#pragma unroll
            for (int j = 0; j < 16; ++j) { const float d = v[j] - mean; q += d * d; }
#pragma unroll
            for (int o = 1; o < 64; o <<= 1) q += __shfl_xor(q, o);
            if (lane == 0) { st[2 * tk] = mean; st[2 * tk + 1] = 1.0f / sqrtf(q * (1.0f / 1024.0f) + 1e-6f); } }
        __syncthreads();
        u32x4 raw[4];
#define GM_LOAD(g_) do { _Pragma("unroll") for (int i = 0; i < 4; ++i) { const int idx = tid + 512 * i, s = idx >> 4, ch = idx & 15; raw[i] = *(const u32x4*)(A.VG + (size_t)(tok0 + s) * 1024 + 128 * (g_) + 8 * ch); } } while (0)
#define GM_WRITE(g_, buf_) do { _Pragma("unroll") for (int i = 0; i < 4; ++i) { const int idx = tid + 512 * i, s = idx >> 4, ch = idx & 15; const float mean = st[2 * s], rstd = st[2 * s + 1]; \
            const f32x4 g0 = *(const f32x4*)(A.ln_g + 128 * (g_) + 8 * ch), g1 = *(const f32x4*)(A.ln_g + 128 * (g_) + 8 * ch + 4), b0 = *(const f32x4*)(A.ln_b + 128 * (g_) + 8 * ch), b1 = *(const f32x4*)(A.ln_b + 128 * (g_) + 8 * ch + 4); \
            const u32x4 x = raw[i]; \
            const unsigned w0 = cvtpk((lo16(x.x) - mean) * rstd * g0.x + b0.x, (hi16(x.x) - mean) * rstd * g0.y + b0.y), w1 = cvtpk((lo16(x.y) - mean) * rstd * g0.z + b0.z, (hi16(x.y) - mean) * rstd * g0.w + b0.w); \
            const unsigned w2 = cvtpk((lo16(x.z) - mean) * rstd * g1.x + b1.x, (hi16(x.z) - mean) * rstd * g1.y + b1.y), w3 = cvtpk((lo16(x.w) - mean) * rstd * g1.z + b1.z, (hi16(x.w) - mean) * rstd * g1.w + b1.w); \
            const int f = (s & 3) | (((s >> 3) & 1) << 2); const u32x4 o = (f & 1) ? (u32x4){w2, w3, w0, w1} : (u32x4){w0, w1, w2, w3}; \
            *(LAS u32x4*)(lds + (buf_) * 32768 + s * 256 + ((ch ^ (f >> 1)) << 4)) = o; } } while (0)
        bf16x8 wf[4];
#define GM_WS(g_) do { _Pragma("unroll") for (int ks = 0; ks < 4; ++ks) wf[ks] = *(const bf16x8*)(A.GWS + (size_t)(g_) * 16384 + (size_t)(16 * w + fr) * 128 + 32 * ks + 8 * fq); } while (0)
        GM_LOAD(0); GM_WRITE(0, 0);
        __syncthreads();
        for (int g = 0; g < 8; ++g) {
            GM_WS(g);
            if (g < 7) GM_LOAD(g + 1);
            f32x4 acc[8];
#pragma unroll
            for (int n = 0; n < 8; ++n) acc[n] = (f32x4){0.f, 0.f, 0.f, 0.f};
            const int tb = (g & 1) * 32768 + rbase;
#pragma unroll
            for (int ks = 0; ks < 4; ++ks)
#pragma unroll
                for (int n = 0; n < 8; ++n) { const int a0 = (tb ^ (n << 3)) + ks * 8192; const s16x4 x = vtr(L3 + a0), y = vtr(L3 + a0 + 1024);
                    const bf16x8 vf = (bf16x8){x[0], x[1], x[2], x[3], y[0], y[1], y[2], y[3]};
                    acc[n] = __builtin_amdgcn_mfma_f32_16x16x32_bf16(vf, wf[ks], acc[n], 0, 0, 0); }
            { const int t = 16 * w + fr; const size_t tok = (size_t)(tok0 + t); const float bias = A.bs[g * 128 + t];
              const u32x4* up = (const u32x4*)(A.U + tok * 1024 + 128 * g + 32 * fq); u32x4* yp = (u32x4*)(A.YC + tok * 1536 + 128 * g + 32 * fq);
#pragma unroll
              for (int k = 0; k < 4; ++k) { const u32x4 u = up[k]; const f32x4 a = acc[2 * k], b = acc[2 * k + 1]; u32x4 o;
                  o.x = cvtpk(lo16(u.x) * (a.x + bias), hi16(u.x) * (a.y + bias)); o.y = cvtpk(lo16(u.y) * (a.z + bias), hi16(u.y) * (a.w + bias));
                  o.z = cvtpk(lo16(u.z) * (b.x + bias), hi16(u.z) * (b.y + bias)); o.w = cvtpk(lo16(u.w) * (b.z + bias), hi16(u.w) * (b.w + bias)); yp[k] = o; } }
            if (g < 7) GM_WRITE(g + 1, (g + 1) & 1);
            __syncthreads();
        }
#undef GM_LOAD
#undef GM_WRITE
#undef GM_WS
        for (int i = 0; i < 16; ++i) { const int idx = tid + 512 * i, tk = idx >> 6, h = (idx >> 3) & 7, d8 = idx & 7; const int token = tok0 + tk, b = token >> 13, t = token & 8191;
            float ls[3]; u32x4 ov[3];
#pragma unroll
            for (int g = 0; g < 3; ++g) { const int dlog = 2 * g, r = t & ((1 << dlog) - 1), l = t >> dlog; const size_t hr = (size_t)(((g * 4 + b) * 8 + h) * 8192 + r * (8192 >> dlog) + l);
                ov[g] = *(const u32x4*)(A.Ob + hr * 64 + 8 * d8); ls[g] = A.LSE[((size_t)g * 32768 + token) * 8 + h]; }
            const float mx = fmaxf(fmaxf(ls[0], ls[1]), ls[2]); float w0 = __builtin_amdgcn_exp2f(ls[0] - mx), w1 = __builtin_amdgcn_exp2f(ls[1] - mx), w2 = __builtin_amdgcn_exp2f(ls[2] - mx);
            const float inv = 1.0f / (w0 + w1 + w2); w0 *= inv; w1 *= inv; w2 *= inv;
            u32x4 o;
            o.x = cvtpk(w0 * lo16(ov[0].x) + w1 * lo16(ov[1].x) + w2 * lo16(ov[2].x), w0 * hi16(ov[0].x) + w1 * hi16(ov[1].x) + w2 * hi16(ov[2].x));
            o.y = cvtpk(w0 * lo16(ov[0].y) + w1 * lo16(ov[1].y) + w2 * lo16(ov[2].y), w0 * hi16(ov[0].y) + w1 * hi16(ov[1].y) + w2 * hi16(ov[2].y));
            o.z = cvtpk(w0 * lo16(ov[0].z) + w1 * lo16(ov[1].z) + w2 * lo16(ov[2].z), w0 * hi16(ov[0].z) + w1 * hi16(ov[1].z) + w2 * hi16(ov[2].z));
            o.w = cvtpk(w0 * lo16(ov[0].w) + w1 * lo16(ov[1].w) + w2 * lo16(ov[2].w), w0 * hi16(ov[0].w) + w1 * hi16(ov[1].w) + w2 * hi16(ov[2].w));
            *(u32x4*)(A.YC + (size_t)token * 1536 + 1024 + 64 * h + 8 * d8) = o; }
        __syncthreads();
    }
}
}

__device__ __forceinline__ void final_norm(Frame& F, const Args& a) {
    const float* SQ = (const float*)(a.ws + WS_SQ2); const float* g = a.in[14]; float* out = a.out;
    const int gw = F.vcu * NWAVES + F.wave, NGW = F.G * NWAVES;
    f32x4 gv[4];
#pragma unroll
    for (int j = 0; j < 4; ++j) gv[j] = *((const GAS f32x4*)g + F.lane + 64 * j);
    for (int m = gw; m < M; m += NGW) {
        float s = F.lane < 16 ? SQ[(size_t)m * 16 + F.lane] : 0.f; s = wave_sum(s);
        const float rstd = 1.f / sqrtf(s * (1.f / D) + NORM_EPS);
        GAS f32x4* xr = (GAS f32x4*)(out + (size_t)m * D) + F.lane;
#pragma unroll
        for (int j = 0; j < 4; ++j) { const f32x4 v = xr[64 * j]; xr[64 * j] = v * rstd * gv[j]; }
    }
}

__global__ void __launch_bounds__(NWAVES * 64, 2) mk_fwd(Args args) {
    extern __shared__ __attribute__((aligned(16))) unsigned char lds[];
    Frame F;
    F.lds = (LAS unsigned char*)lds;
    F.MISC = (volatile LAS unsigned*)(F.lds + MISC_OFF);
#define REFRAME() do { int t_ = threadIdx.x; asm volatile("" : "+v"(t_)); F.tid = t_; F.lane = t_ & 63; F.wave = __builtin_amdgcn_readfirstlane(t_ >> 6); } while (0)
    REFRAME();
    F.G = gridDim.x; { const int bx = blockIdx.x; F.vcu = (F.G % 8 == 0) ? (bx % 8) * (F.G / 8) + bx / 8 : bx; }
    unsigned char* ws = args.ws;
    F.ctl = (gu32*)(ws + WS_CTL);
    for (int u = F.tid; u < (LDS_BYTES - LDSCTL_OFF) / 4; u += NWAVES * 64) ((LAS unsigned*)(F.lds + LDSCTL_OFF))[u] = 0u;
    __syncthreads();
    XcdBarrier bar; bar.bar = (unsigned*)(F.ctl + CW_BAR); bar.x = 0; bar.st = nullptr;
    if (N_LAUNCHES != PER_PHASE) bar = xcd_barrier_post((unsigned*)(F.ctl + CW_BAR), F.MISC + 8);
#define GRID_BAR() do { if (N_LAUNCHES != PER_PHASE) xcd_barrier(bar); } while (0)
    const int lo = args.ph_lo, hi = args.ph_hi;
#define IN(k) (lo <= (k) && (k) < hi)
#define BOTH(k) (IN(k) && IN((k) + 1))
    bf16* XN = (bf16*)args.out;
    bf16* WIN = (bf16*)(ws + WS_WIN);

    if (IN(0)) {
_Pragma("nounroll") for (int rep = 0; rep < REP_P0; ++rep) { REFRAME(); p0_prologue(F, args); if (BOTH(0)) GRID_BAR(); } }

    if (IN(1))
_Pragma("nounroll") for (int rep = 0; rep < REP_P1; ++rep) {
        pg8::Gemm g{XN, WIN, M, NP1, D}; pg8::StaticOrder S; S.init(M, NP1, F.G, (int)blockIdx.x);
        pg8::EpiProj E{(bf16*)(ws + WS_R)};
        pg8::gemm_phase<pg8::EpiProj, pg8::StaticOrder, true, true>(F.lds + RING_OFF, g, S, E);
        if (BOTH(1)) GRID_BAR();
    }
    if (IN(2)) { att::attn_phase(F.lds + RING_OFF, F.vcu, F.G, (bf16*)(ws + WS_Q), (const bf16*)(ws + WS_K), (const bf16*)(ws + WS_V), (float*)(ws + WS_LSE)); if (BOTH(2)) GRID_BAR(); }
    if (IN(3))
_Pragma("nounroll") for (int rep = 0; rep < REP_P2B; ++rep) { const gm::GmlpArgs GA{(const bf16*)(ws + WS_U), (const bf16*)(ws + WS_VG), (const bf16*)(ws + WS_Q), (const bf16*)(ws + WS_GWS), (const float*)(ws + WS_LSE), args.in[3], args.in[4], args.in[6], (bf16*)(ws + WS_YCAT)};
        gm::gmlp_phase(F.lds + RING_OFF, (LAS float*)(F.lds + RING_BYTES + 1024), F.vcu, F.G, GA); if (BOTH(3)) GRID_BAR(); }
    if (IN(4))
_Pragma("nounroll") for (int rep = 0; rep < REP_P3; ++rep) {
        { pg8::Gemm g{XN, WIN + (size_t)NP1 * D, M, NGATE, D}; pg8::GateOrder S; S.init(M, F.G, (int)blockIdx.x);
          pg8::EpiGate E{(bf16*)(ws + WS_SG)};
          pg8::gemm_phase<pg8::EpiGate, pg8::GateOrder, true, true>(F.lds + RING_OFF, g, S, E); }
        { pg8::Gemm g{(const bf16*)(ws + WS_YCAT), (const bf16*)(ws + WS_WAB), M, D, KCAT}; pg8::StaticOrder S; S.init(M, D, F.G, (int)blockIdx.x);
          pg8::EpiMerge E{(const bf16*)(ws + WS_SG), (bf16*)(ws + WS_MRG)};
          pg8::gemm_phase<pg8::EpiMerge, pg8::StaticOrder, true, true>(F.lds + RING_OFF, g, S, E); }
        if (BOTH(4)) GRID_BAR();
    }
    if (IN(5))
_Pragma("nounroll") for (int rep = 0; rep < REP_P4; ++rep) {
        pg8::Gemm g{(const bf16*)(ws + WS_MRG), (const bf16*)(ws + WS_WOUT), M, D, D}; pg8::StaticOrder S; S.init(M, D, F.G, (int)blockIdx.x);
        pg8::EpiRes E{args.in[0], args.out, (bf16*)(ws + WS_H1B), (float*)(ws + WS_SQ1)};
        pg8::gemm_phase<pg8::EpiRes, pg8::StaticOrder, true, true>(F.lds + RING_OFF, g, S, E);
        if (BOTH(5)) GRID_BAR();
    }
    if (IN(6))
_Pragma("nounroll") for (int rep = 0; rep < REP_P5; ++rep) {
        pg8::Gemm g{(const bf16*)(ws + WS_H1B), (const bf16*)(ws + WS_WGU), M, FF2, D}; pg8::StaticOrder S; S.init(M, FF2, F.G, (int)blockIdx.x);
        pg8::EpiSwiglu E{(const float*)(ws + WS_SQ1), (bf16*)(ws + WS_ACT), NORM_EPS};
        pg8::gemm_phase<pg8::EpiSwiglu, pg8::StaticOrder, true, true>(F.lds + RING_OFF, g, S, E);
        if (BOTH(6)) GRID_BAR();
    }
    if (IN(7)) {
        pg8::Gemm g{(const bf16*)(ws + WS_ACT), (const bf16*)(ws + WS_WDN), M, D, FF}; pg8::StaticOrder S; S.init(M, D, F.G, (int)blockIdx.x);
        pg8::EpiRes E{args.out, args.out, nullptr, (float*)(ws + WS_SQ2)};
        pg8::gemm_phase<pg8::EpiRes, pg8::StaticOrder, true, true>(F.lds + RING_OFF, g, S, E);
        if (BOTH(7)) GRID_BAR();
    }
    if (IN(8)) { REFRAME(); final_norm(F, args); }
#undef IN
#undef BOTH
}

extern "C" void kernel_launch(void* const* d_in, const int* in_sizes, int n_in, void* d_out, int out_size, void* d_ws, size_t ws_size, hipStream_t stream) {
    static int grid = 0;
    if (grid == 0) {
        if (n_in != 15 || out_size != M * D || ws_size < WS_END) { fprintf(stderr, "kernel_launch: unexpected shapes: n_in %d out %d ws %zu (need >= %zu)\n", n_in, out_size, ws_size, (size_t)WS_END); grid = -1; return; }
        int dev = 0, cus = 0, per_cu = 0;
        if (hipGetDevice(&dev) != hipSuccess || hipDeviceGetAttribute(&cus, hipDeviceAttributeMultiprocessorCount, dev) != hipSuccess) { grid = -1; return; }
        if (hipFuncSetAttribute((const void*)mk_fwd, hipFuncAttributeMaxDynamicSharedMemorySize, LDS_BYTES) != hipSuccess) { fprintf(stderr, "kernel_launch: hipFuncSetAttribute failed\n"); grid = -1; return; }
        if (hipOccupancyMaxActiveBlocksPerMultiprocessor(&per_cu, (const void*)mk_fwd, NWAVES * 64, LDS_BYTES) != hipSuccess || per_cu < 1)
            fprintf(stderr, "kernel_launch: occupancy query reports %d workgroups per CU\n", per_cu);
        (void)hipGetLastError();
        grid = cus;
    }
    if (grid < 0) return;
    if (hipMemsetAsync((char*)d_ws + WS_CTL, 0, CTL_ZERO_BYTES, stream) != hipSuccess) { fprintf(stderr, "kernel_launch: hipMemsetAsync failed\n"); return; }
    Args a{};
    for (int i = 0; i < 15; ++i) a.in[i] = (const float*)d_in[i];
    a.out = (float*)d_out; a.ws = (unsigned char*)d_ws;
    for (int li = 0; li < N_LAUNCHES; ++li) {
        a.ph_lo = (N_LAUNCHES == PER_PHASE) ? li : 0; a.ph_hi = (N_LAUNCHES == PER_PHASE) ? li + 1 : PER_PHASE;
        hipLaunchKernelGGL(mk_fwd, dim3(grid), dim3(NWAVES * 64), LDS_BYTES, stream, a);
        const hipError_t le = hipPeekAtLastError();
        if (le != hipSuccess) { fprintf(stderr, "kernel_launch: launch %d failed: %s\n", li, hipGetErrorName(le)); break; }
    }
}
```

```cpp
#include <hip/hip_runtime.h>
#include <cstdio>
#include <cstdint>
namespace pg8 {
#define PG8_LAS __attribute__((address_space(3)))
typedef unsigned short bf16_t;
typedef short bf16x8 __attribute__((ext_vector_type(8)));
typedef float f32x4 __attribute__((ext_vector_type(4)));
typedef unsigned u32x4 __attribute__((ext_vector_type(4)));
constexpr int BM = 256, BK = 64, HALF = 128, HTB = HALF * BK * 2  , STAGE_BYTES = 8 * HTB, NXCD = 8, WGM = 8;

__host__ __device__ __forceinline__ int lds_byte(int r, int c) { const int st = (r >> 4) * 2 + (c >> 5), rr = r & 15, cc = c & 31, ob = rr * 64 + cc * 2; return st * 1024 + (ob ^ (((ob >> 9) & 1) << 5)); }
__host__ __device__ __forceinline__ void stage_rc(int b, int& R, int& C) { const int st = b / 1024, sb = b % 1024, swz = sb ^ (((sb >> 9) & 1) << 5); R = (st >> 1) * 16 + swz / 64; C = (st & 1) * 32 + (swz % 64) / 2; }
__host__ __device__ __forceinline__ int perm32(int rho) { const int n = rho >> 4, i = rho & 15; return 8 * (i >> 2) + 4 * n + (i & 3); }

struct Unit { int pm, pn; };
struct Gemm { const bf16_t* A; const bf16_t* Bt; int M, N, K; };

struct StaticOrder {
    int nM, nN, nwg, G, c;
    __host__ __device__ void init(int M, int N, int G_, int c_) { nM = M / BM; nN = N / BM; nwg = nM * nN; G = G_; c = c_; }
    __host__ __device__ bool next(int i, Unit& u) const {
        const long L = (long)i * G + c; if (L >= nwg) return false;
        int wgid = (int)L; { const int q = nwg / NXCD, r = nwg % NXCD, xcd = wgid % NXCD, off = wgid / NXCD; wgid = (xcd < r ? xcd * (q + 1) : r * (q + 1) + (xcd - r) * q) + off; }
        const int nig = WGM * nN, gid = wgid / nig, fm = gid * WGM, gsz = (nM - fm) < WGM ? (nM - fm) : WGM;
        u.pm = fm + ((wgid % nig) % gsz); u.pn = (wgid % nig) / gsz; return true;
    }
    __device__ __forceinline__ void a_ready(const Unit&) const {}
    __device__ __forceinline__ void done(const Unit&) const {}
};

__device__ __forceinline__ unsigned cvt_pk_bf16(float lo, float hi) { unsigned r; asm volatile("v_cvt_pk_bf16_f32 %0, %1, %2" : "=v"(r) : "v"(lo), "v"(hi)); return r; }
typedef float f32x2 __attribute__((ext_vector_type(2)));
__device__ __forceinline__ f32x2 gelu_pk(f32x2 v) {
    const f32x2 av = __builtin_elementwise_abs(v), d = av * 0.2316418882f + 1.0f;
    f32x2 t; t.x = __builtin_amdgcn_rcpf(d.x); t.y = __builtin_amdgcn_rcpf(d.y);
    f32x2 q = t * 0.5307027145f + (-0.7265760135f); q = q * t + 0.7107068705f; q = q * t + (-0.142248368f); q = q * t + 0.127414796f; q = q * t;
    const f32x2 s = (v * v) * (-0.72134752044f);
    f32x2 e; e.x = __builtin_amdgcn_exp2f(s.x); e.y = __builtin_amdgcn_exp2f(s.y);
    const f32x2 m = v * (q * e), r = v - m;
    f32x2 o; o.x = v.x < 0.f ? m.x : r.x; o.y = v.y < 0.f ? m.y : r.y; return o;
}


__device__ __forceinline__ float sigmoid_f(float x) { return __builtin_amdgcn_rcpf(1.0f + __builtin_amdgcn_exp2f(-1.4426950408889634f * x)); }
__device__ __forceinline__ float bf_lo(unsigned w) { return __uint_as_float(w << 16); }
__device__ __forceinline__ float bf_hi(unsigned w) { return __uint_as_float(w & 0xffff0000u); }
constexpr float QK_C2 = 0.125f * 1.4426950408889634f;

struct EpiProj {
    static constexpr bool PERM = true, AFTER_DRAIN = false; static constexpr int HOOK_T = -1;
    bf16_t* RB;
    __device__ __forceinline__ void hook(f32x4 (&)[2][2][4][2], const Unit&, int, int, int, int) const {}
    __device__ __forceinline__ void operator()(const f32x4 (&acc)[2][2][4][2], const Unit& u, int wr, int wc, int fr, int fq) const {
        asm volatile("" : "+v"(fr), "+v"(fq));
        const int pn = u.pn, row0 = u.pm * BM + wr * 64 + fr;
        if (pn < 8) {
            bf16_t* base = RB + (size_t)(pn >> 2) * (32u << 20); const int col0 = (pn & 3) * BM + wc * 32 + 8 * fq;
#pragma unroll
            for (int ai = 0; ai < 2; ++ai)
#pragma unroll
                for (int m = 0; m < 4; ++m) { bf16_t* rowp = base + (size_t)(row0 + ai * HALF + m * 16) * 1024 + col0;
#pragma unroll
                    for (int bj = 0; bj < 2; ++bj) { const f32x4 v0 = acc[ai][bj][m][0], v1 = acc[ai][bj][m][1];
                        const f32x2 a = gelu_pk((f32x2){v0[0], v0[1]}), b = gelu_pk((f32x2){v0[2], v0[3]}), c = gelu_pk((f32x2){v1[0], v1[1]}), d = gelu_pk((f32x2){v1[2], v1[3]});
                        u32x4 w; w.x = cvt_pk_bf16(a.x, a.y); w.y = cvt_pk_bf16(b.x, b.y); w.z = cvt_pk_bf16(c.x, c.y); w.w = cvt_pk_bf16(d.x, d.y);
                        *(u32x4*)(rowp + bj * HALF) = w; } }
        } else {
            const int t6 = pn - 8, which = t6 / 6, rem = t6 - which * 6, g = rem >> 1, half = rem & 1, dlog = 2 * g;
            bf16_t* base = RB + (size_t)(64u << 20) + (size_t)which * (48u << 20); const float sc = which == 0 ? QK_C2 : 1.0f;
#pragma unroll
            for (int bj = 0; bj < 2; ++bj) { const int cg = half * 256 + bj * HALF + wc * 32 + 8 * fq, h = cg >> 6, dd = cg & 63;
#pragma unroll
                for (int ai = 0; ai < 2; ++ai)
#pragma unroll
                    for (int m = 0; m < 4; ++m) { const int row = row0 + ai * HALF + m * 16, b = row >> 13, t = row & 8191, r = t & ((1 << dlog) - 1), l = t >> dlog;
                        const size_t hr = (size_t)(((g * 4 + b) * 8 + h) * 8192 + r * (8192 >> dlog) + l);
                        const f32x4 v0 = acc[ai][bj][m][0] * sc, v1 = acc[ai][bj][m][1] * sc;
                        u32x4 w; w.x = cvt_pk_bf16(v0[0], v0[1]); w.y = cvt_pk_bf16(v0[2], v0[3]); w.z = cvt_pk_bf16(v1[0], v1[1]); w.w = cvt_pk_bf16(v1[2], v1[3]);
                        *(u32x4*)(base + hr * 64 + dd) = w; } }
        }
    }
};

struct EpiGate {
    static constexpr bool PERM = true, AFTER_DRAIN = false; static constexpr int HOOK_T = -1;
    bf16_t* SG;
    __device__ __forceinline__ void hook(f32x4 (&)[2][2][4][2], const Unit&, int, int, int, int) const {}
    __device__ __forceinline__ void operator()(const f32x4 (&acc)[2][2][4][2], const Unit& u, int wr, int wc, int fr, int fq) const {
        asm volatile("" : "+v"(fr), "+v"(fq));
        const int row0 = u.pm * BM + wr * 64 + fr, j0 = u.pn * HALF + wc * 32 + 8 * fq;
#pragma unroll
        for (int ai = 0; ai < 2; ++ai)
#pragma unroll
            for (int m = 0; m < 4; ++m) { bf16_t* rowp = SG + (size_t)(row0 + ai * HALF + m * 16) * 2048 + j0;
                float rr[8], sb[8];
#pragma unroll
                for (int n = 0; n < 2; ++n)
#pragma unroll
                    for (int i = 0; i < 4; ++i) { const float ea = __builtin_amdgcn_exp2f(-1.4426950408889634f * acc[ai][0][m][n][i]), eb = __builtin_amdgcn_exp2f(-1.4426950408889634f * acc[ai][1][m][n][i]);
                        const float s = __builtin_amdgcn_rcpf(1.0f + eb); sb[n * 4 + i] = s; rr[n * 4 + i] = (1.0f + eb) * __builtin_amdgcn_rcpf(1.0f + ea); }
                u32x4 w; w.x = cvt_pk_bf16(rr[0], rr[1]); w.y = cvt_pk_bf16(rr[2], rr[3]); w.z = cvt_pk_bf16(rr[4], rr[5]); w.w = cvt_pk_bf16(rr[6], rr[7]);
                *(u32x4*)(rowp) = w;
                u32x4 x; x.x = cvt_pk_bf16(sb[0], sb[1]); x.y = cvt_pk_bf16(sb[2], sb[3]); x.z = cvt_pk_bf16(sb[4], sb[5]); x.w = cvt_pk_bf16(sb[6], sb[7]);
                *(u32x4*)(rowp + 1024) = x; }
    }
};

struct EpiMerge {
    static constexpr bool PERM = true, AFTER_DRAIN = false; static constexpr int HOOK_T = 16;
    const bf16_t* SG; bf16_t* O;
    __device__ __forceinline__ void hook(f32x4 (&acc)[2][2][4][2], const Unit& u, int wr, int wc, int fr, int fq) const {
        asm volatile("" : "+v"(fr), "+v"(fq));
        const int row0 = u.pm * BM + wr * 64 + fr, col0 = u.pn * BM + wc * 32 + 8 * fq;
#pragma unroll
        for (int ai = 0; ai < 2; ++ai)
#pragma unroll
            for (int m = 0; m < 4; ++m) { const bf16_t* rowp = SG + (size_t)(row0 + ai * HALF + m * 16) * 2048 + col0;
#pragma unroll
                for (int bj = 0; bj < 2; ++bj) { const u32x4 w = *(const u32x4*)(rowp + bj * HALF);
                    acc[ai][bj][m][0] = acc[ai][bj][m][0] * (f32x4){bf_lo(w.x), bf_hi(w.x), bf_lo(w.y), bf_hi(w.y)};
                    acc[ai][bj][m][1] = acc[ai][bj][m][1] * (f32x4){bf_lo(w.z), bf_hi(w.z), bf_lo(w.w), bf_hi(w.w)}; } }
    }
    __device__ __forceinline__ void operator()(const f32x4 (&acc)[2][2][4][2], const Unit& u, int wr, int wc, int fr, int fq) const {
        asm volatile("" : "+v"(fr), "+v"(fq));
        const int row0 = u.pm * BM + wr * 64 + fr, col0 = u.pn * BM + wc * 32 + 8 * fq;
        u32x4 sbv[2][4][2];
#pragma unroll
        for (int ai = 0; ai < 2; ++ai)
#pragma unroll
            for (int m = 0; m < 4; ++m)
#pragma unroll
                for (int bj = 0; bj < 2; ++bj) sbv[ai][m][bj] = *(const u32x4*)(SG + (size_t)(row0 + ai * HALF + m * 16) * 2048 + 1024 + col0 + bj * HALF);
        asm volatile("" ::: "memory");
#pragma unroll
        for (int ai = 0; ai < 2; ++ai)
#pragma unroll
            for (int m = 0; m < 4; ++m) { const size_t row = (size_t)(row0 + ai * HALF + m * 16);
#pragma unroll
                for (int bj = 0; bj < 2; ++bj) { const u32x4 w = sbv[ai][m][bj];
                    const f32x4 v0 = acc[ai][bj][m][0] * (f32x4){bf_lo(w.x), bf_hi(w.x), bf_lo(w.y), bf_hi(w.y)};
                    const f32x4 v1 = acc[ai][bj][m][1] * (f32x4){bf_lo(w.z), bf_hi(w.z), bf_lo(w.w), bf_hi(w.w)};
                    u32x4 o; o.x = cvt_pk_bf16(v0[0], v0[1]); o.y = cvt_pk_bf16(v0[2], v0[3]); o.z = cvt_pk_bf16(v1[0], v1[1]); o.w = cvt_pk_bf16(v1[2], v1[3]);
                    *(u32x4*)(O + row * 1024 + col0 + bj * HALF) = o; } }
    }
};

struct EpiRes1 {
    static constexpr bool PERM = true, AFTER_DRAIN = false; static constexpr int HOOK_T = -1;
    const float* base; bf16_t* outb; float* SQ;
    __device__ __forceinline__ void hook(f32x4 (&)[2][2][4][2], const Unit&, int, int, int, int) const {}
    __device__ __forceinline__ void operator()(const f32x4 (&acc)[2][2][4][2], const Unit& u, int wr, int wc, int fr, int fq) const {
        asm volatile("" : "+v"(fr), "+v"(fq));
        const int row0 = u.pm * BM + wr * 64 + fr, col0 = u.pn * BM + wc * 32 + 8 * fq;
#pragma unroll
        for (int ai = 0; ai < 2; ++ai) {
            f32x4 pre[4][2][2];
#pragma unroll
            for (int m = 0; m < 4; ++m)
#pragma unroll
                for (int bj = 0; bj < 2; ++bj)
#pragma unroll
                    for (int n = 0; n < 2; ++n) pre[m][bj][n] = *(const f32x4*)(base + (size_t)(row0 + ai * HALF + m * 16) * 1024 + col0 + bj * HALF + n * 4);
            asm volatile("" ::: "memory");
#pragma unroll
            for (int m = 0; m < 4; ++m) { const int row = row0 + ai * HALF + m * 16; const size_t off = (size_t)row * 1024 + col0; float ss = 0.f;
#pragma unroll
                for (int bj = 0; bj < 2; ++bj) { const f32x4 h0 = pre[m][bj][0] + acc[ai][bj][m][0], h1 = pre[m][bj][1] + acc[ai][bj][m][1];
                    ss += ((h0[0] * h0[0] + h0[1] * h0[1]) + (h0[2] * h0[2] + h0[3] * h0[3])) + ((h1[0] * h1[0] + h1[1] * h1[1]) + (h1[2] * h1[2] + h1[3] * h1[3]));
                    u32x4 w; w.x = cvt_pk_bf16(h0[0], h0[1]); w.y = cvt_pk_bf16(h0[2], h0[3]); w.z = cvt_pk_bf16(h1[0], h1[1]); w.w = cvt_pk_bf16(h1[2], h1[3]);
                    *(u32x4*)(outb + off + bj * HALF) = w; }
                ss += __shfl_xor(ss, 16); ss += __shfl_xor(ss, 32);
                if (fq == 0) SQ[(size_t)row * 16 + u.pn * 4 + wc] = ss; }
            asm volatile("" ::: "memory");
        }
    }
};
struct EpiRes2 {
    static constexpr bool PERM = false, AFTER_DRAIN = false; static constexpr int HOOK_T = -1;
    const bf16_t* base; float* out; float* SQ;
    __device__ __forceinline__ void hook(f32x4 (&)[2][2][4][2], const Unit&, int, int, int, int) const {}
    __device__ __forceinline__ void operator()(const f32x4 (&acc)[2][2][4][2], const Unit& u, int wr, int wc, int fr, int fq) const {
        typedef unsigned u32x2v __attribute__((ext_vector_type(2)));
        asm volatile("" : "+v"(fr), "+v"(fq));
        const int row0 = u.pm * BM + wr * 64 + fr, col0 = u.pn * BM + wc * 32 + 4 * fq;
        u32x2v pre[2][4][2][2];
#pragma unroll
        for (int ai = 0; ai < 2; ++ai)
#pragma unroll
            for (int m = 0; m < 4; ++m)
#pragma unroll
                for (int bj = 0; bj < 2; ++bj)
#pragma unroll
                    for (int n = 0; n < 2; ++n) pre[ai][m][bj][n] = *(const u32x2v*)(base + (size_t)(row0 + ai * HALF + m * 16) * 1024 + col0 + bj * HALF + n * 16);
        asm volatile("" ::: "memory");
#pragma unroll
        for (int ai = 0; ai < 2; ++ai)
#pragma unroll
            for (int m = 0; m < 4; ++m) { const int row = row0 + ai * HALF + m * 16; const size_t off = (size_t)row * 1024 + col0; float ss = 0.f;
#pragma unroll
                for (int bj = 0; bj < 2; ++bj)
#pragma unroll
                    for (int n = 0; n < 2; ++n) { const u32x2v b = pre[ai][m][bj][n]; const f32x4 h = (f32x4){bf_lo(b.x), bf_hi(b.x), bf_lo(b.y), bf_hi(b.y)} + acc[ai][bj][m][n];
                        *(f32x4*)(out + off + bj * HALF + n * 16) = h; ss += (h[0] * h[0] + h[1] * h[1]) + (h[2] * h[2] + h[3] * h[3]); }
                ss += __shfl_xor(ss, 16); ss += __shfl_xor(ss, 32);
                if (fq == 0) SQ[(size_t)row * 16 + u.pn * 4 + wc] = ss; }
    }
};

struct EpiSwiglu {
    static constexpr bool PERM = true, AFTER_DRAIN = false; static constexpr int HOOK_T = -1;
    const float* SQ; bf16_t* ACT; float eps;
    __device__ __forceinline__ void hook(f32x4 (&)[2][2][4][2], const Unit&, int, int, int, int) const {}
    __device__ __forceinline__ void operator()(const f32x4 (&acc)[2][2][4][2], const Unit& u, int wr, int wc, int fr, int fq) const {
        asm volatile("" : "+v"(fr), "+v"(fq));
        const int row0 = u.pm * BM + wr * 64 + fr, j0 = u.pn * HALF + wc * 32 + 8 * fq;
        f32x4 p4v[2][4];
#pragma unroll
        for (int ai = 0; ai < 2; ++ai)
#pragma unroll
            for (int m = 0; m < 4; ++m) p4v[ai][m] = *(const f32x4*)(SQ + (size_t)(row0 + ai * HALF + m * 16) * 16 + 4 * fq);
        asm volatile("" ::: "memory");
#pragma unroll
        for (int ai = 0; ai < 2; ++ai)
#pragma unroll
            for (int m = 0; m < 4; ++m) { const int row = row0 + ai * HALF + m * 16;
                const f32x4 p4 = p4v[ai][m]; float ss = (p4[0] + p4[1]) + (p4[2] + p4[3]);
                ss += __shfl_xor(ss, 16); ss += __shfl_xor(ss, 32);
                const float rstd = 1.0f / sqrtf(ss * (1.0f / 1024.0f) + eps);
                float o[8];
#pragma unroll
                for (int n = 0; n < 2; ++n)
#pragma unroll
                    for (int i = 0; i < 4; ++i) { const float gt = acc[ai][0][m][n][i] * rstd, up = acc[ai][1][m][n][i] * rstd; o[n * 4 + i] = gt * sigmoid_f(gt) * up; }
                u32x4 w; w.x = cvt_pk_bf16(o[0], o[1]); w.y = cvt_pk_bf16(o[2], o[3]); w.z = cvt_pk_bf16(o[4], o[5]); w.w = cvt_pk_bf16(o[6], o[7]);
                *(u32x4*)(ACT + (size_t)row * 2816 + j0) = w; }
    }
};

struct GateOrder {
    StaticOrder S1;
    __host__ __device__ void init(int M, int G_, int c_) { S1.init(M, 1024, G_, c_); }
    __host__ __device__ bool next(int i, Unit& u) const { Unit t; if (!S1.next(i >> 1, t)) return false; u.pm = t.pm; u.pn = 2 * t.pn + (i & 1); return true; }
    __device__ __forceinline__ void a_ready(const Unit&) const {}
    __device__ __forceinline__ void done(const Unit&) const {}
};

template <class Epi, class Sched, bool ALIGN_EPI = false, bool SP2 = false>
__device__ __forceinline__ void gemm_phase(PG8_LAS unsigned char* lds, const Gemm g, const Sched& S, const Epi& E) {
    const int tid = threadIdx.x, wid = __builtin_amdgcn_readfirstlane(tid >> 6), lane = tid & 63, wr = wid >> 2, wc = wid & 3, fr = lane & 15, fq = lane >> 4;
    const int K = g.K, nt = K / BK;
    unsigned voffA[2], voffB[2];
#pragma unroll
    for (int i = 0; i < 2; ++i) { int R, C; stage_rc(tid * 16 + i * 8192, R, C); const int Rb = Epi::PERM ? ((R & ~31) + perm32(R & 31)) : R;
        voffA[i] = (unsigned)(R * K + C) * 2u; voffB[i] = (unsigned)(Rb * K + C) * 2u; }
    const size_t kstep = (size_t)(BK * 2);
    const size_t hstep = (size_t)HALF * K * 2;
    const size_t tstep = 2 * hstep;
    const unsigned ldsw = (unsigned)wid * 1024u;
    const int aoff = lds_byte(wr * 64 + fr, fq * 8), boff = lds_byte(wc * 32 + fr, fq * 8);
#define PG8_SA(b, h) (((b) * 2 + (h)) * HTB)
#define PG8_SB(b, h) ((4 + (b) * 2 + (h)) * HTB)
#define PG8_STAGE(bufoff, gbase, voff) do { _Pragma("unroll") for (int _i = 0; _i < 2; ++_i) \
        __builtin_amdgcn_global_load_lds((const unsigned*)((const char*)(gbase) + (voff)[_i]), (PG8_LAS unsigned*)(lds + (bufoff) + ldsw + _i * 8192), 16, 0, 0); } while (0)
#define PG8_LDA(dst, b, h) do { _Pragma("unroll") for (int m = 0; m < 4; ++m) _Pragma("unroll") for (int k = 0; k < 2; ++k) dst[m][k] = *(const PG8_LAS bf16x8*)(lds + PG8_SA(b, h) + aoff + m * 2048 + k * 1024); } while (0)
#define PG8_LDB(dst, b, h) do { _Pragma("unroll") for (int n = 0; n < 2; ++n) _Pragma("unroll") for (int k = 0; k < 2; ++k) dst[n][k] = *(const PG8_LAS bf16x8*)(lds + PG8_SB(b, h) + boff + n * 2048 + k * 1024); } while (0)
#define PG8_MMA(ai, bj, At, Bt) do { __builtin_amdgcn_s_setprio(1); _Pragma("unroll") for (int m = 0; m < 4; ++m) _Pragma("unroll") for (int n = 0; n < 2; ++n) _Pragma("unroll") for (int k = 0; k < 2; ++k) \
        acc[ai][bj][m][n] = __builtin_amdgcn_mfma_f32_16x16x32_bf16(Bt[n][k], At[m][k], acc[ai][bj][m][n], 0, 0, 0); __builtin_amdgcn_s_setprio(0); } while (0)
#define PG8_WAIT_V(n) asm volatile("s_waitcnt vmcnt(" #n ")" ::: "memory")
#define PG8_WAIT_L(n) asm volatile("s_waitcnt lgkmcnt(" #n ")" ::: "memory")
#define PG8_BAR __builtin_amdgcn_s_barrier()
#define PG8_SCHED __builtin_amdgcn_sched_barrier(0)
    Unit cur, nxt; int ui = 0;
    if (!S.next(0, cur)) return;
    f32x4 acc[2][2][4][2];
#pragma unroll
    for (int a = 0; a < 2; ++a)
#pragma unroll
        for (int b = 0; b < 2; ++b)
#pragma unroll
            for (int m = 0; m < 4; ++m)
#pragma unroll
                for (int n = 0; n < 2; ++n) acc[a][b][m][n] = (f32x4){0.f, 0.f, 0.f, 0.f};
    bf16x8 At[4][2], B0[2][2], B1[2][2];
    const char* cA = (const char*)g.A + (size_t)cur.pm * tstep; const char* cB = (const char*)g.Bt + (size_t)cur.pn * tstep;
    S.a_ready(cur);
    if constexpr (SP2) {
        PG8_STAGE(PG8_SB(0, 0), cB, voffB); PG8_STAGE(PG8_SB(0, 1), cB + hstep, voffB); PG8_STAGE(PG8_SA(0, 0), cA, voffA); PG8_STAGE(PG8_SA(0, 1), cA + hstep, voffA);
        if (wr == 1) PG8_BAR;
        PG8_WAIT_V(2); PG8_BAR;
        PG8_STAGE(PG8_SB(1, 0), cB + kstep, voffB); PG8_STAGE(PG8_SA(1, 0), cA + kstep, voffA); PG8_STAGE(PG8_SB(1, 1), cB + hstep + kstep, voffB);
        PG8_WAIT_V(6); PG8_BAR;
    } else {
        PG8_STAGE(PG8_SB(0, 0), cB, voffB); PG8_STAGE(PG8_SA(0, 0), cA, voffA); PG8_STAGE(PG8_SB(0, 1), cB + hstep, voffB); PG8_STAGE(PG8_SA(0, 1), cA + hstep, voffA);
        if (wr == 1) PG8_BAR;
        PG8_WAIT_V(4); PG8_BAR;
        PG8_STAGE(PG8_SB(1, 0), cB + kstep, voffB); PG8_STAGE(PG8_SA(1, 0), cA + kstep, voffA); PG8_STAGE(PG8_SB(1, 1), cB + hstep + kstep, voffB);
        PG8_WAIT_V(6); PG8_BAR;
    }
    for (;;) {
        const bool has_next = S.next(ui + 1, nxt);
        const char* nA = has_next ? (const char*)g.A + (size_t)nxt.pm * tstep : cA; const char* nB = has_next ? (const char*)g.Bt + (size_t)nxt.pn * tstep : cB;
        for (int t = 0; t < nt; t += 2) {
            if constexpr (Epi::HOOK_T >= 0) { if (t == Epi::HOOK_T) E.hook(acc, cur, wr, wc, fr, fq); }
            const bool last = (t == nt - 2);
            const char* a1 = cA + (size_t)(t + 1) * kstep;
            const char* a2 = last ? nA : cA + (size_t)(t + 2) * kstep; const char* b2 = last ? nB : cB + (size_t)(t + 2) * kstep;
            const char* a3 = a2 + kstep; const char* b3 = b2 + kstep;
            if (last && has_next) S.a_ready(nxt);
            if constexpr (SP2) {
            PG8_LDB(B0, 0, 0); PG8_LDB(B1, 0, 1); PG8_SCHED; PG8_LDA(At, 0, 0); PG8_STAGE(PG8_SA(1, 1), a1 + hstep, voffA);
            PG8_WAIT_V(8); PG8_WAIT_L(0); PG8_BAR; PG8_MMA(0, 0, At, B0); PG8_MMA(0, 1, At, B1); PG8_BAR; PG8_SCHED;
            PG8_LDA(At, 0, 1); PG8_STAGE(PG8_SB(0, 0), b2, voffB); PG8_STAGE(PG8_SB(0, 1), b2 + hstep, voffB); PG8_STAGE(PG8_SA(0, 0), a2, voffA);
            PG8_WAIT_V(8); PG8_WAIT_L(0); PG8_BAR; PG8_MMA(1, 0, At, B0); PG8_MMA(1, 1, At, B1); PG8_BAR; PG8_SCHED;
            PG8_LDB(B0, 1, 0); PG8_LDB(B1, 1, 1); PG8_SCHED; PG8_LDA(At, 1, 0); PG8_STAGE(PG8_SA(0, 1), a2 + hstep, voffA);
            PG8_WAIT_V(8); PG8_WAIT_L(0); PG8_BAR; PG8_MMA(0, 0, At, B0); PG8_MMA(0, 1, At, B1); PG8_BAR; PG8_SCHED;
            PG8_LDA(At, 1, 1); PG8_STAGE(PG8_SB(1, 0), b3, voffB); PG8_STAGE(PG8_SB(1, 1), b3 + hstep, voffB); PG8_STAGE(PG8_SA(1, 0), a3, voffA);
            PG8_WAIT_V(8); PG8_WAIT_L(0); PG8_BAR; PG8_MMA(1, 0, At, B0); PG8_MMA(1, 1, At, B1); PG8_BAR; PG8_SCHED;
            } else {
            PG8_LDB(B0, 0, 0); PG8_SCHED; PG8_LDA(At, 0, 0); PG8_STAGE(PG8_SA(1, 1), a1 + hstep, voffA);
            PG8_WAIT_L(8); PG8_BAR; PG8_WAIT_L(0); PG8_MMA(0, 0, At, B0); PG8_BAR; PG8_SCHED;
            PG8_LDB(B1, 0, 1); PG8_STAGE(PG8_SB(0, 0), b2, voffB);
            PG8_BAR; PG8_WAIT_L(0); PG8_MMA(0, 1, At, B1); PG8_BAR;
            PG8_LDA(At, 0, 1); PG8_STAGE(PG8_SA(0, 0), a2, voffA);
            PG8_BAR; PG8_WAIT_L(0); PG8_MMA(1, 0, At, B0); PG8_BAR; PG8_SCHED;
            PG8_STAGE(PG8_SB(0, 1), b2 + hstep, voffB);
            PG8_WAIT_V(6); PG8_BAR; PG8_MMA(1, 1, At, B1); PG8_BAR;
            PG8_LDB(B0, 1, 0); PG8_SCHED; PG8_LDA(At, 1, 0); PG8_STAGE(PG8_SA(0, 1), a2 + hstep, voffA);
            PG8_WAIT_L(8); PG8_BAR; PG8_WAIT_L(0); PG8_MMA(0, 0, At, B0); PG8_BAR; PG8_SCHED;
            PG8_LDB(B1, 1, 1); PG8_STAGE(PG8_SB(1, 0), b3, voffB);
            PG8_BAR; PG8_WAIT_L(0); PG8_MMA(0, 1, At, B1); PG8_BAR;
            PG8_LDA(At, 1, 1); PG8_STAGE(PG8_SA(1, 0), a3, voffA);
            PG8_BAR; PG8_WAIT_L(0); PG8_MMA(1, 0, At, B0); PG8_BAR; PG8_SCHED;
            PG8_STAGE(PG8_SB(1, 1), b3 + hstep, voffB);
            PG8_WAIT_V(6); PG8_BAR; PG8_MMA(1, 1, At, B1); PG8_BAR;
            }
        }
        if constexpr (ALIGN_EPI) { if (wr == 0) PG8_BAR; }
        if constexpr (!Epi::AFTER_DRAIN) { E(acc, cur, wr, wc, fr, fq); S.done(cur); }
        if (!has_next) break;
#pragma unroll
        for (int a = 0; a < 2; ++a)
#pragma unroll
            for (int b = 0; b < 2; ++b)
#pragma unroll
                for (int m = 0; m < 4; ++m)
#pragma unroll
                    for (int n = 0; n < 2; ++n) acc[a][b][m][n] = (f32x4){0.f, 0.f, 0.f, 0.f};
        cur = nxt; cA = nA; cB = nB; ++ui;
        if constexpr (ALIGN_EPI) { if (wr == 1) PG8_BAR; }
    }
    PG8_WAIT_V(0);
    if constexpr (!ALIGN_EPI) { if (wr == 0) PG8_BAR; }
    PG8_BAR;
    if constexpr (Epi::AFTER_DRAIN) { E.fused(acc, cur, wr, wc, fr, fq, lds, wid, lane); S.done(cur); }
#undef PG8_SA
#undef PG8_SB
#undef PG8_STAGE
#undef PG8_LDA
#undef PG8_LDB
#undef PG8_MMA
#undef PG8_WAIT_V
#undef PG8_WAIT_L
#undef PG8_BAR
#undef PG8_SCHED
}
}

#define GAS __attribute__((address_space(1)))
#define LAS __attribute__((address_space(3)))
typedef unsigned short bf16;
typedef unsigned v4u __attribute__((ext_vector_type(4)));
typedef float f32x4 __attribute__((ext_vector_type(4)));
typedef short bf16x8 __attribute__((ext_vector_type(8)));
typedef GAS unsigned gu32;
typedef GAS unsigned long long gu64;
#define RLX_AGENT __ATOMIC_RELAXED, __HIP_MEMORY_SCOPE_AGENT
#define LDS_WAIT() asm volatile("s_waitcnt lgkmcnt(0)" ::: "memory")
#define VM_WAIT() asm volatile("s_waitcnt vmcnt(0)" ::: "memory")
__device__ __forceinline__ unsigned long long rt() { return __builtin_amdgcn_s_memrealtime(); }
__device__ __forceinline__ unsigned f2bf(float f) { unsigned u = __builtin_bit_cast(unsigned, f); return (u + 0x7fffu + ((u >> 16) & 1u)) >> 16; }
__device__ __forceinline__ unsigned pk2(float lo, float hi) { return f2bf(lo) | (f2bf(hi) << 16); }

#define XB_TMO      128
#define XB_XCNT(j)  (256  + 64 * (j))
#define XB_XSUB(j)  (1280 + 64 * (j))
#define XB_XGEN(j)  (2304 + 64 * (j))
#define XB_TOP      3328
#define XB_TOPGEN   3392
#define XCD_BAR_WORDS 3456
#define XB_SPIN_CAP (1u << 18)

__device__ __forceinline__ unsigned xb_ld(unsigned* p)              { return __hip_atomic_load(p, __ATOMIC_RELAXED, __HIP_MEMORY_SCOPE_AGENT); }
__device__ __forceinline__ unsigned xb_add(unsigned* p, unsigned v) { return __hip_atomic_fetch_add(p, v, __ATOMIC_RELAXED, __HIP_MEMORY_SCOPE_AGENT); }
__device__ __forceinline__ unsigned xb_xcc_id() { return (unsigned)__builtin_amdgcn_s_getreg((3 << 11) | 20) & 0xFu; }
#define XB_SPIN(cond, bar) do { unsigned _sp = 0; while (cond) { __builtin_amdgcn_s_sleep(1); \
    if ((++_sp & 255u) == 0u) { if (xb_ld(&(bar)[XB_TMO])) break; if (_sp > XB_SPIN_CAP) { atomicAdd(&(bar)[XB_TMO], 1u); break; } } } } while (0)

struct XcdBarrier {
    unsigned* bar; unsigned x;
    volatile LAS unsigned* st;
};

__device__ __forceinline__ XcdBarrier xcd_barrier_post(unsigned* bar, volatile LAS unsigned* st) {
    XcdBarrier b; b.bar = bar; b.x = xb_xcc_id(); b.st = st;
    if (threadIdx.x == 0) (void)xb_add(&bar[XB_XCNT(b.x)], 1u);
    return b;
}
__device__ __forceinline__ void xcd_barrier_complete(unsigned* bar, unsigned x, unsigned& nloc, unsigned& nx) {
    const unsigned G = gridDim.x * gridDim.y * gridDim.z;
    unsigned sum, cnt, mine, sp = 0u;
    for (;;) {
        sum = 0u; cnt = 0u; mine = 0u;
#pragma unroll
        for (unsigned j = 0; j < 16; ++j) { const unsigned c = xb_ld(&bar[XB_XCNT(j)]); sum += c; cnt += (c > 0u) ? 1u : 0u; mine = (j == x) ? c : mine; }
        if (sum == G) break;
        __builtin_amdgcn_s_sleep(1);
        if ((++sp & 255u) == 0u) { if (xb_ld(&bar[XB_TMO])) break; if (sp > XB_SPIN_CAP) { atomicAdd(&bar[XB_TMO], 1u); break; } }
    }
    nloc = mine > 0u ? mine : 1u; nx = cnt > 0u ? cnt : 1u;
}

__device__ __forceinline__ void xcd_barrier(const XcdBarrier& b) {
    asm volatile("s_waitcnt vmcnt(0)" ::: "memory");
    __syncthreads();
    if (threadIdx.x == 0) {
        unsigned* bar = b.bar;
        __builtin_amdgcn_s_waitcnt(0);
        unsigned nloc = b.st[0], nx = b.st[1];
        if (nloc == 0u) { xcd_barrier_complete(bar, b.x, nloc, nx); b.st[0] = nloc; b.st[1] = nx; }
        const unsigned old = xb_add(&bar[XB_XSUB(b.x)], 1u);
        const unsigned gen = old / nloc;
        if (old + 1u == (gen + 1u) * nloc) {
            __builtin_amdgcn_fence(__ATOMIC_RELEASE, "agent");
            asm volatile("s_waitcnt vmcnt(0)" ::: "memory");
            const unsigned og = xb_add(&bar[XB_TOP], 1u);
            const unsigned tg = og / nx;
            if (og + 1u == (tg + 1u) * nx) xb_add(&bar[XB_TOPGEN], 1u);
            else XB_SPIN(xb_ld(&bar[XB_TOPGEN]) == tg, bar);
            __builtin_amdgcn_fence(__ATOMIC_ACQUIRE, "agent");
            xb_add(&bar[XB_XGEN(b.x)], 1u);
            asm volatile("s_waitcnt vmcnt(0)" ::: "memory");
        } else {
            XB_SPIN(xb_ld(&bar[XB_XGEN(b.x)]) == gen, bar);
            __builtin_amdgcn_fence(__ATOMIC_ACQUIRE, "agent");
            asm volatile("s_waitcnt vmcnt(0)" ::: "memory");
        }
    }
    __syncthreads();
}


constexpr int NWAVES = 8;
#ifndef MK_N_LAUNCHES
#define MK_N_LAUNCHES 1
#endif
#ifndef REP_P0
#define REP_P0 1
#endif
#ifndef REP_P1
#define REP_P1 1
#endif
#ifndef REP_P2B
#define REP_P2B 1
#endif
#ifndef REP_P3
#define REP_P3 1
#endif
#ifndef REP_P4
#define REP_P4 1
#endif
#ifndef REP_P5
#define REP_P5 1
#endif
constexpr int PER_PHASE = 9;
constexpr int N_LAUNCHES = MK_N_LAUNCHES;

constexpr int BATCH = 4, SEQ = 8192, D = 1024, M = BATCH * SEQ, NP1 = 6656, NGATE = 2048, FF = 2816, FF2 = 5632, KCAT = 1536;
constexpr float NORM_EPS = 1e-6f;
constexpr int NHR = 3 * BATCH * 8 * SEQ;

constexpr size_t MiB = 1u << 20;
constexpr size_t WS_CTL = 0, CTL_ZERO_BYTES = 1 * MiB;
constexpr size_t WS_WIN = 2 * MiB;
constexpr size_t WS_WAB = 19 * MiB;
constexpr size_t WS_WOUT = 22 * MiB;
constexpr size_t WS_WGU = 24 * MiB;
constexpr size_t WS_WDN = 35 * MiB;
constexpr size_t WS_GWS = 41 * MiB;
constexpr size_t WS_SQ1 = 42 * MiB;
constexpr size_t WS_SQ2 = 44 * MiB;
constexpr size_t WS_LSE = 46 * MiB;
constexpr size_t WS_R = 50 * MiB;
constexpr size_t WS_U = WS_R, WS_VG = WS_R + 64 * MiB, WS_Q = WS_R + 128 * MiB, WS_K = WS_R + 224 * MiB, WS_V = WS_R + 320 * MiB;
constexpr size_t WS_YCAT = WS_K;
constexpr size_t WS_SG = WS_R;
constexpr size_t WS_MRG = WS_V;
constexpr size_t WS_H1B = WS_K;
constexpr size_t WS_ACT = WS_R;
constexpr size_t WS_END = WS_R + 416 * MiB;

constexpr int RING_OFF = 0, RING_BYTES = 131072;
constexpr int LDSCTL_OFF = RING_BYTES, MISC_OFF = LDSCTL_OFF + 320;
constexpr int LDS_BYTES = 147456;
constexpr int CW_BAR = 4096;

struct Args { const float* in[15]; float* out; unsigned char* ws; int ph_lo, ph_hi; };

struct Frame {
    LAS unsigned char* lds;
    volatile LAS unsigned* MISC;
    gu32* ctl;
    int tid, lane, wave, vcu, G;
};

__device__ __forceinline__ float wave_sum(float v) {
#pragma unroll
    for (int o = 1; o < 64; o <<= 1) v += __shfl_xor(v, o);
    return v;
}
__device__ __forceinline__ float wave_max(float v) {
#pragma unroll
    for (int o = 1; o < 64; o <<= 1) v = fmaxf(v, __shfl_xor(v, o));
    return v;
}
__device__ __forceinline__ float bf2f(unsigned short h) { return __uint_as_float((unsigned)h << 16); }

__device__ __forceinline__ void p0_transpose_item(const float* W, int K, int N, int ncol0, bf16* WT, int ldk, int k_off, int mode, int row_off, const float* kscale, LAS float* scr, int item, int nblk, int lane) {
    const int kb = item / nblk, nb = item % nblk, k0 = 64 * kb, n0 = 32 * nb;
#pragma unroll 8
    for (int i = 0; i < 32; ++i) { const int kk = 2 * i + (lane >> 5); float v = W[(size_t)(k0 + kk) * N + ncol0 + n0 + (lane & 31)]; if (kscale) v *= kscale[k0 + kk]; scr[kk * 33 + (lane & 31)] = v; }
    LDS_WAIT(); asm volatile("" ::: "memory");
    const int c = lane & 7; const int drow0 = mode == 0 ? row_off + n0 : ((n0 >> 7) << 8) + (n0 & 127) + row_off;
#pragma unroll
    for (int j = 0; j < 4; ++j) { const int n = (lane >> 3) + 8 * j; const LAS float* s = scr + (8 * c) * 33 + n;
        v4u o; o.x = pk2(s[0 * 33], s[1 * 33]); o.y = pk2(s[2 * 33], s[3 * 33]); o.z = pk2(s[4 * 33], s[5 * 33]); o.w = pk2(s[6 * 33], s[7 * 33]);
        *(GAS v4u*)(WT + (size_t)(drow0 + n) * ldk + k_off + k0 + 8 * c) = o; }
    LDS_WAIT(); asm volatile("" ::: "memory");
}
__device__ __forceinline__ void p0_prologue(Frame& F, const Args& a) {
    unsigned char* ws = a.ws;
    LAS float* scr = (LAS float*)(F.lds + RING_OFF + F.wave * 16384);
    const int gw = F.vcu * NWAVES + F.wave, NGW = F.G * NWAVES;
    constexpr int I_P1 = 16 * (NP1 / 32), I_G = 16 * (1024 / 32), I_A = 16 * 32, I_B = 8 * 32, I_O = 16 * 32, I_F = 16 * (FF / 32), I_D = (FF / 64) * 32;
    constexpr int NITEMS = I_P1 + 2 * I_G + I_A + I_B + I_O + 2 * I_F + I_D;
    const float* w_in = a.in[2];
    for (int it = gw; it < NITEMS; it += NGW) {
        int r = it;
        if (r < I_P1) { p0_transpose_item(w_in, D, 8704, 0, (bf16*)(ws + WS_WIN), D, 0, 0, 0, nullptr, scr, r, NP1 / 32, F.lane); continue; } r -= I_P1;
        if (r < I_G) { p0_transpose_item(w_in, D, 8704, 6656, (bf16*)(ws + WS_WIN), D, 0, 1, 6656, nullptr, scr, r, 32, F.lane); continue; } r -= I_G;
        if (r < I_G) { p0_transpose_item(w_in, D, 8704, 7680, (bf16*)(ws + WS_WIN), D, 0, 1, 6656 + 128, nullptr, scr, r, 32, F.lane); continue; } r -= I_G;
        if (r < I_A) { p0_transpose_item(a.in[7], 1024, 1024, 0, (bf16*)(ws + WS_WAB), KCAT, 0, 0, 0, nullptr, scr, r, 32, F.lane); continue; } r -= I_A;
        if (r < I_B) { p0_transpose_item(a.in[8], 512, 1024, 0, (bf16*)(ws + WS_WAB), KCAT, 1024, 0, 0, nullptr, scr, r, 32, F.lane); continue; } r -= I_B;
        if (r < I_O) { p0_transpose_item(a.in[9], 1024, 1024, 0, (bf16*)(ws + WS_WOUT), D, 0, 0, 0, nullptr, scr, r, 32, F.lane); continue; } r -= I_O;
        if (r < I_F) { p0_transpose_item(a.in[11], D, FF, 0, (bf16*)(ws + WS_WGU), D, 0, 1, 0, a.in[10], scr, r, FF / 32, F.lane); continue; } r -= I_F;
        if (r < I_F) { p0_transpose_item(a.in[12], D, FF, 0, (bf16*)(ws + WS_WGU), D, 0, 1, 128, a.in[10], scr, r, FF / 32, F.lane); continue; } r -= I_F;
        p0_transpose_item(a.in[13], FF, D, 0, (bf16*)(ws + WS_WDN), FF, 0, 0, 0, nullptr, scr, r, 32, F.lane);
    }
    { const float* gws = a.in[5]; bf16* o = (bf16*)(ws + WS_GWS); const int gt = F.vcu * (NWAVES * 64) + F.tid, NT = F.G * NWAVES * 64;
      for (int i = gt; i < 8 * 128 * 128 / 2; i += NT) ((GAS unsigned*)o)[i] = pk2(gws[2 * i], gws[2 * i + 1]); }
    { const float* x = a.in[0]; const float* g = a.in[1]; bf16* XN = (bf16*)a.out;
      f32x4 gv[4];
#pragma unroll
      for (int j = 0; j < 4; ++j) gv[j] = *((const GAS f32x4*)g + F.lane + 64 * j);
      for (int m = gw; m < M; m += NGW) {
        const GAS f32x4* xr = (const GAS f32x4*)(x + (size_t)m * D) + F.lane; f32x4 v[4]; float s = 0.f;
#pragma unroll
        for (int j = 0; j < 4; ++j) { v[j] = xr[64 * j]; s += (v[j].x * v[j].x + v[j].y * v[j].y) + (v[j].z * v[j].z + v[j].w * v[j].w); }
        const float rstd = 1.f / sqrtf(wave_sum(s) * (1.f / D) + NORM_EPS);
        GAS unsigned long long* o8 = (GAS unsigned long long*)(XN + (size_t)m * D) + F.lane;
#pragma unroll
        for (int j = 0; j < 4; ++j) o8[64 * j] = (unsigned long long)pk2(v[j].x * rstd * gv[j].x, v[j].y * rstd * gv[j].y) | ((unsigned long long)pk2(v[j].z * rstd * gv[j].z, v[j].w * rstd * gv[j].w) << 32);
      } }
}

__device__ __forceinline__ void attn_simple(Frame& F, bf16* Qb, const bf16* Kb, const bf16* Vb, float* LSE) {
    const int gw = F.vcu * NWAVES + F.wave, NGW = F.G * NWAVES, lane = F.lane;
    for (int R = gw; R < NHR; R += NGW) {
        const int g = R >> 18, rem = R & 262143, b = rem >> 16, h = (rem >> 13) & 7, p = rem & 8191;
        const int dlog = 2 * g, L = 8192 >> dlog, l = p & (L - 1), r = p >> (13 - dlog);
        const int seq0 = R - l;
        const float slope2 = __builtin_amdgcn_exp2f(-(float)(g * 8 + h + 1) * (1.0f / 3.0f)) * (float)(1 << dlog) * 1.4426950408889634f;
        float q[64];
        { const GAS v4u* qp = (const GAS v4u*)(Qb + (size_t)R * 64);
#pragma unroll
          for (int c = 0; c < 8; ++c) { const v4u w = qp[c];
            q[8 * c + 0] = __uint_as_float(w.x << 16); q[8 * c + 1] = __uint_as_float(w.x & 0xffff0000u); q[8 * c + 2] = __uint_as_float(w.y << 16); q[8 * c + 3] = __uint_as_float(w.y & 0xffff0000u);
            q[8 * c + 4] = __uint_as_float(w.z << 16); q[8 * c + 5] = __uint_as_float(w.z & 0xffff0000u); q[8 * c + 6] = __uint_as_float(w.w << 16); q[8 * c + 7] = __uint_as_float(w.w & 0xffff0000u); } }
        float s[3]; bool ok[3];
#pragma unroll
        for (int ps = 0; ps < 3; ++ps) {
            const int j = lane + 64 * ps - 64, kl = l + j; ok[ps] = (j <= 64) && (kl >= 0) && (kl < L);
            const int klc = kl < 0 ? 0 : (kl > L - 1 ? L - 1 : kl);
            const GAS v4u* kp = (const GAS v4u*)(Kb + (size_t)(seq0 + klc) * 64); float acc = 0.f;
#pragma unroll
            for (int c = 0; c < 8; ++c) { const v4u w = kp[c];
                acc += q[8 * c + 0] * __uint_as_float(w.x << 16) + q[8 * c + 1] * __uint_as_float(w.x & 0xffff0000u) + q[8 * c + 2] * __uint_as_float(w.y << 16) + q[8 * c + 3] * __uint_as_float(w.y & 0xffff0000u)
                     + q[8 * c + 4] * __uint_as_float(w.z << 16) + q[8 * c + 5] * __uint_as_float(w.z & 0xffff0000u) + q[8 * c + 6] * __uint_as_float(w.w << 16) + q[8 * c + 7] * __uint_as_float(w.w & 0xffff0000u); }
            const float aj = (float)(j < 0 ? -j : j);
            s[ps] = ok[ps] ? acc - slope2 * aj : -1e30f;
        }
        const float mx = wave_max(fmaxf(fmaxf(s[0], s[1]), s[2]));
        float pr[3]; float ls = 0.f;
#pragma unroll
        for (int ps = 0; ps < 3; ++ps) { pr[ps] = ok[ps] ? __builtin_amdgcn_exp2f(s[ps] - mx) : 0.f; ls += pr[ps]; }
        ls = wave_sum(ls);
        float o = 0.f;
#pragma unroll
        for (int ps = 0; ps < 3; ++ps) {
            const int nj = ps == 2 ? 1 : 64;
            for (int jj = 0; jj < nj; ++jj) {
                const float pj = __uint_as_float((unsigned)__builtin_amdgcn_readlane((int)__float_as_uint(pr[ps]), jj));
                int kl = l + jj + 64 * ps - 64; kl = kl < 0 ? 0 : (kl > L - 1 ? L - 1 : kl);
                o += pj * bf2f(Vb[(size_t)(seq0 + kl) * 64 + lane]);
            }
        }
        o = o / ls;
        Qb[(size_t)R * 64 + lane] = (bf16)f2bf(o);
        if (lane == 0) { const int token = b * SEQ + (l << dlog) + r; LSE[((size_t)g * M + token) * 8 + h] = mx + __builtin_amdgcn_logf(ls); }
    }
}

namespace att {
typedef short bf16x8 __attribute__((ext_vector_type(8)));
typedef short s16x4 __attribute__((ext_vector_type(4)));
typedef float f32x16 __attribute__((ext_vector_type(16)));
typedef unsigned u32x2 __attribute__((ext_vector_type(2)));
typedef __attribute__((address_space(3))) const unsigned char* lds_cptr;
constexpr int IMG_ROWS = 384, LDS_K = 0, LDS_V = IMG_ROWS * 128;
__device__ __forceinline__ int sw(int row) { return (((row >> 1) & 1) << 2) | (((row >> 2) & 1) << 1) | ((row >> 3) & 1); }
__device__ __forceinline__ void glds16(const void* gsrc, unsigned lds_dst) { unsigned keep;
    asm volatile("s_mov_b32 %0, m0\n\ts_mov_b32 m0, %2\n\ts_nop 0\n\tglobal_load_lds_dwordx4 %1, off\n\ts_mov_b32 m0, %0" : "=&s"(keep) : "v"(gsrc), "s"(lds_dst) : "memory"); }
__device__ __forceinline__ s16x4 vtr(lds_cptr p) { typedef short v4i16_t __attribute__((ext_vector_type(4))); return __builtin_bit_cast(s16x4, __builtin_amdgcn_ds_read_tr16_b64_v4i16((__attribute__((address_space(3))) v4i16_t*)p)); }
__device__ __forceinline__ unsigned cvtpk(float lo, float hi) { typedef float f2 __attribute__((ext_vector_type(2))); typedef __bf16 b2 __attribute__((ext_vector_type(2))); f2 v = {lo, hi}; b2 b = __builtin_convertvector(v, b2); return __builtin_bit_cast(unsigned, b); }

__device__ __forceinline__ void attn_phase(LAS unsigned char* lds, int vcu, int G, unsigned short* Qb, const unsigned short* Kb, const unsigned short* Vb, float* LSE) {
    int tid_ = threadIdx.x; asm volatile("" : "+v"(tid_));
    const int lane = tid_ & 63, w = __builtin_amdgcn_readfirstlane(tid_ >> 6), ql = lane & 31, hi = lane >> 5;
    const unsigned lds0 = (unsigned)(uintptr_t)lds;
    const lds_cptr L3 = (lds_cptr)lds;
    const int swl = sw(ql);
    int koff[4];
#pragma unroll
    for (int d0 = 0; d0 < 4; ++d0) koff[d0] = LDS_K + (32 * w + ql) * 128 + (((2 * d0 + hi) ^ swl) << 4);
    const int p_ = lane & 3, qrow = (lane & 15) >> 2, gi = (lane >> 4) & 1;
    const int sw0 = ((qrow >> 1) << 2) | (hi << 1);
    int voff[2][2];
#pragma unroll
    for (int dh = 0; dh < 2; ++dh)
#pragma unroll
        for (int sec = 0; sec < 2; ++sec) voff[dh][sec] = LDS_V + (32 * w + 4 * hi + qrow + 8 * sec) * 128 + (((4 * dh + 2 * gi + (p_ >> 1)) ^ (sw0 | sec)) << 4) + (p_ & 1) * 8;
    const float fbase = (float)(4 * hi - ql - 64);
    constexpr int NUNITS = 3 * 4 * 8 * 8192 / 256;
    for (int U = vcu; U < NUNITS; U += G) {
        const int R0 = U * 256, g = R0 >> 18, rem = R0 & 262143, b = rem >> 16, h = (rem >> 13) & 7, p0 = rem & 8191;
        const int dlog = 2 * g, L = 8192 >> dlog, l0 = p0 & (L - 1), r = p0 >> (13 - dlog), seq0 = R0 - l0;
        const float slope2 = __builtin_amdgcn_exp2f(-(float)(g * 8 + h + 1) * (1.0f / 3.0f)) * (float)(1 << dlog) * 1.4426950408889634f;
        __syncthreads();
#pragma unroll
        for (int i = 0; i < 6; ++i) { const int pc = w * 6 + i, row = 8 * pc + (lane >> 3); int ls = l0 - 64 + row; ls = ls < 0 ? 0 : (ls > L - 1 ? L - 1 : ls);
            const size_t eo = (size_t)(seq0 + ls) * 64 + (size_t)(((lane & 7) ^ sw(row)) << 3);
            glds16(Kb + eo, (unsigned)__builtin_amdgcn_readfirstlane(lds0 + LDS_K + pc * 1024));
            glds16(Vb + eo, (unsigned)__builtin_amdgcn_readfirstlane(lds0 + LDS_V + pc * 1024)); }
        bf16x8 qr[4];
        { const unsigned short* qp = Qb + (size_t)(R0 + 32 * w + ql) * 64 + 8 * hi;
#pragma unroll
          for (int d0 = 0; d0 < 4; ++d0) qr[d0] = *(const bf16x8*)(qp + 16 * d0); }
        asm volatile("s_waitcnt vmcnt(0)" ::: "memory");
        __syncthreads();
        f32x16 p[5];
#pragma unroll
        for (int t = 0; t < 5; ++t) {
            p[t] = (f32x16){0.f, 0.f, 0.f, 0.f, 0.f, 0.f, 0.f, 0.f, 0.f, 0.f, 0.f, 0.f, 0.f, 0.f, 0.f, 0.f};
#pragma unroll
            for (int d0 = 0; d0 < 4; ++d0) { const bf16x8 kf = *(const __attribute__((address_space(3))) bf16x8*)(L3 + koff[d0] + t * 4096); p[t] = __builtin_amdgcn_mfma_f32_32x32x16_bf16(kf, qr[d0], p[t], 0, 0, 0); }
        }
        const int kv0 = l0 + 32 * w - 64;
        float mx = -INFINITY;
#pragma unroll
        for (int t = 0; t < 5; ++t) {
            const bool tv = (kv0 + 32 * t >= 0) && (kv0 + 32 * t + 31 < L);
#pragma unroll
            for (int r16 = 0; r16 < 16; ++r16) { const float fd = fbase + (float)(32 * t + (r16 & 3) + 8 * (r16 >> 2));
                float s = __builtin_fmaf(-slope2, __builtin_fabsf(fd), p[t][r16]);
                if (t == 0) s = (fd >= -64.0f) ? s : -INFINITY;
                if (t == 4) s = (fd <= 64.0f) ? s : -INFINITY;
                s = tv ? s : -INFINITY;
                p[t][r16] = s; mx = fmaxf(mx, s); }
        }
        mx = fmaxf(mx, __shfl_xor(mx, 32));
        float lsum = 0.f;
#pragma unroll
        for (int t = 0; t < 5; ++t)
#pragma unroll
            for (int r16 = 0; r16 < 16; ++r16) { const float e = __builtin_amdgcn_exp2f(p[t][r16] - mx); p[t][r16] = e; lsum += e; }
        lsum += __shfl_xor(lsum, 32);
        f32x16 o[2];
        o[0] = (f32x16){0.f, 0.f, 0.f, 0.f, 0.f, 0.f, 0.f, 0.f, 0.f, 0.f, 0.f, 0.f, 0.f, 0.f, 0.f, 0.f}; o[1] = o[0];
#pragma unroll
        for (int t = 0; t < 5; ++t)
#pragma unroll
            for (int s2 = 0; s2 < 2; ++s2) {
                typedef unsigned u32x4 __attribute__((ext_vector_type(4)));
                u32x4 pw; pw.x = cvtpk(p[t][8 * s2 + 0], p[t][8 * s2 + 1]); pw.y = cvtpk(p[t][8 * s2 + 2], p[t][8 * s2 + 3]); pw.z = cvtpk(p[t][8 * s2 + 4], p[t][8 * s2 + 5]); pw.w = cvtpk(p[t][8 * s2 + 6], p[t][8 * s2 + 7]);
                const bf16x8 pf = __builtin_bit_cast(bf16x8, pw);
#pragma unroll
                for (int dh = 0; dh < 2; ++dh) { const s16x4 a = vtr(L3 + voff[dh][0] + t * 4096 + s2 * 2048), c = vtr(L3 + voff[dh][1] + t * 4096 + s2 * 2048);
                    const bf16x8 vf = (bf16x8){a[0], a[1], a[2], a[3], c[0], c[1], c[2], c[3]};
                    o[dh] = __builtin_amdgcn_mfma_f32_32x32x16_bf16(vf, pf, o[dh], 0, 0, 0); }
            }
        const float rl = 1.0f / lsum;
        unsigned short* op = Qb + (size_t)(R0 + 32 * w + ql) * 64 + 4 * hi;
#pragma unroll
        for (int dh = 0; dh < 2; ++dh)
#pragma unroll
            for (int k4 = 0; k4 < 4; ++k4) { u32x2 v; v.x = cvtpk(o[dh][4 * k4 + 0] * rl, o[dh][4 * k4 + 1] * rl); v.y = cvtpk(o[dh][4 * k4 + 2] * rl, o[dh][4 * k4 + 3] * rl);
                *(u32x2*)(op + 32 * dh + 8 * k4) = v; }
        if (hi == 0) { const int l = l0 + 32 * w + ql, token = b * 8192 + (l << dlog) + r; LSE[((size_t)g * 32768 + token) * 8 + h] = mx + __builtin_amdgcn_logf(lsum); }
    }
    __syncthreads();
}
}

__device__ __forceinline__ void gmlp_merge_simple(Frame& F, const Args& a) {
    unsigned char* ws = a.ws;
    const bf16* U = (const bf16*)(ws + WS_U); const bf16* VG = (const bf16*)(ws + WS_VG); const bf16* Ob = (const bf16*)(ws + WS_Q); const float* LSE = (const float*)(ws + WS_LSE);
    const bf16* GWS = (const bf16*)(ws + WS_GWS); bf16* YC = (bf16*)(ws + WS_YCAT);
    const float* ln_g = a.in[3]; const float* ln_b = a.in[4]; const float* bs = a.in[6];
    LAS float* st = (LAS float*)(F.lds + RING_BYTES + 1024);
    LAS float* vn = (LAS float*)(F.lds);
    LAS float* wsl = (LAS float*)(F.lds + 65536);
    const int tid = F.tid, lane = F.lane, wave = F.wave;
    for (int ci = F.vcu; ci < M / 128; ci += F.G) {
        const int tok0 = ci * 128;
        for (int i = 0; i < 16; ++i) { const int tk = wave * 16 + i; const GAS v4u* rp = (const GAS v4u*)(VG + (size_t)(tok0 + tk) * 1024);
            float v[16];
#pragma unroll
            for (int j = 0; j < 2; ++j) { const v4u w = rp[lane + 64 * j];
                v[8 * j + 0] = __uint_as_float(w.x << 16); v[8 * j + 1] = __uint_as_float(w.x & 0xffff0000u); v[8 * j + 2] = __uint_as_float(w.y << 16); v[8 * j + 3] = __uint_as_float(w.y & 0xffff0000u);
                v[8 * j + 4] = __uint_as_float(w.z << 16); v[8 * j + 5] = __uint_as_float(w.z & 0xffff0000u); v[8 * j + 6] = __uint_as_float(w.w << 16); v[8 * j + 7] = __uint_as_float(w.w & 0xffff0000u); }
            float s = 0.f;
#pragma unroll
            for (int j = 0; j < 16; ++j) s += v[j];
            const float mean = wave_sum(s) * (1.0f / 1024.0f); float q = 0.f;
#pragma unroll
            for (int j = 0; j < 16; ++j) { const float d = v[j] - mean; q += d * d; }
            const float rstd = 1.0f / sqrtf(wave_sum(q) * (1.0f / 1024.0f) + NORM_EPS);
            if (lane == 0) { st[2 * tk] = mean; st[2 * tk + 1] = rstd; } }
        __syncthreads();
        for (int g = 0; g < 8; ++g) {
#pragma unroll
            for (int i = 0; i < 4; ++i) { const int idx = tid + 512 * i, s = idx >> 4, c8 = (idx & 15) * 8;
                const v4u w = *(const GAS v4u*)(VG + (size_t)(tok0 + s) * 1024 + 128 * g + c8); const float mean = st[2 * s], rstd = st[2 * s + 1];
                const float* lg = ln_g + 128 * g + c8; const float* lb = ln_b + 128 * g + c8; LAS float* d = vn + s * 128 + c8;
                d[0] = (__uint_as_float(w.x << 16) - mean) * rstd * lg[0] + lb[0]; d[1] = (__uint_as_float(w.x & 0xffff0000u) - mean) * rstd * lg[1] + lb[1];
                d[2] = (__uint_as_float(w.y << 16) - mean) * rstd * lg[2] + lb[2]; d[3] = (__uint_as_float(w.y & 0xffff0000u) - mean) * rstd * lg[3] + lb[3];
                d[4] = (__uint_as_float(w.z << 16) - mean) * rstd * lg[4] + lb[4]; d[5] = (__uint_as_float(w.z & 0xffff0000u) - mean) * rstd * lg[5] + lb[5];
                d[6] = (__uint_as_float(w.w << 16) - mean) * rstd * lg[6] + lb[6]; d[7] = (__uint_as_float(w.w & 0xffff0000u) - mean) * rstd * lg[7] + lb[7];
                const v4u x = *(const GAS v4u*)(GWS + (size_t)g * 16384 + (size_t)s * 128 + c8); LAS float* e = wsl + s * 128 + c8;
                e[0] = __uint_as_float(x.x << 16); e[1] = __uint_as_float(x.x & 0xffff0000u); e[2] = __uint_as_float(x.y << 16); e[3] = __uint_as_float(x.y & 0xffff0000u);
                e[4] = __uint_as_float(x.z << 16); e[5] = __uint_as_float(x.z & 0xffff0000u); e[6] = __uint_as_float(x.w << 16); e[7] = __uint_as_float(x.w & 0xffff0000u); }
            __syncthreads();
            const int c = tid & 127, tq = tid >> 7;
            float acc[32];
#pragma unroll
            for (int tt = 0; tt < 32; ++tt) acc[tt] = 0.f;
            for (int s = 0; s < 128; s += 4) {
                const float v0 = vn[(s + 0) * 128 + c], v1 = vn[(s + 1) * 128 + c], v2 = vn[(s + 2) * 128 + c], v3 = vn[(s + 3) * 128 + c];
#pragma unroll
                for (int tt = 0; tt < 32; ++tt) { const f32x4 w4 = *(const LAS f32x4*)(wsl + (32 * tq + tt) * 128 + s); acc[tt] += w4.x * v0 + w4.y * v1 + w4.z * v2 + w4.w * v3; }
            }
#pragma unroll
            for (int tt = 0; tt < 32; ++tt) { const int t = 32 * tq + tt; const size_t tok = (size_t)(tok0 + t);
                const float uu = bf2f(U[tok * 1024 + 128 * g + c]); YC[tok * KCAT + 128 * g + c] = (bf16)f2bf(uu * (acc[tt] + bs[g * 128 + t])); }
            __syncthreads();
        }
        for (int i = 0; i < 128; ++i) { const int idx = tid + 512 * i, tk = idx >> 9, ch = idx & 511, h = ch >> 6, dd = ch & 63; const int token = tok0 + tk, b = token >> 13, t = token & 8191;
            float ls[3], ov[3];
#pragma unroll
            for (int g = 0; g < 3; ++g) { const int dlog = 2 * g, r = t & ((1 << dlog) - 1), l = t >> dlog; const size_t hr = (size_t)(((g * 4 + b) * 8 + h) * 8192 + r * (8192 >> dlog) + l);
                ov[g] = bf2f(Ob[hr * 64 + dd]); ls[g] = LSE[((size_t)g * M + token) * 8 + h]; }
            const float mx = fmaxf(fmaxf(ls[0], ls[1]), ls[2]); const float w0 = __builtin_amdgcn_exp2f(ls[0] - mx), w1 = __builtin_amdgcn_exp2f(ls[1] - mx), w2 = __builtin_amdgcn_exp2f(ls[2] - mx);
            YC[(size_t)token * KCAT + 1024 + ch] = (bf16)f2bf((w0 * ov[0] + w1 * ov[1] + w2 * ov[2]) / (w0 + w1 + w2)); }
        __syncthreads();
    }
}

namespace gm {
typedef short bf16x8 __attribute__((ext_vector_type(8)));
typedef short s16x4 __attribute__((ext_vector_type(4)));
typedef float f32x4 __attribute__((ext_vector_type(4)));
typedef unsigned u32x4 __attribute__((ext_vector_type(4)));
typedef __attribute__((address_space(3))) const unsigned char* lds_cptr;
__device__ __forceinline__ s16x4 vtr(lds_cptr p) { typedef short v4i16_t __attribute__((ext_vector_type(4))); return __builtin_bit_cast(s16x4, __builtin_amdgcn_ds_read_tr16_b64_v4i16((__attribute__((address_space(3))) v4i16_t*)p)); }
__device__ __forceinline__ unsigned cvtpk(float lo, float hi) { typedef float f2 __attribute__((ext_vector_type(2))); typedef __bf16 b2 __attribute__((ext_vector_type(2))); f2 v = {lo, hi}; b2 b = __builtin_convertvector(v, b2); return __builtin_bit_cast(unsigned, b); }
__device__ __forceinline__ float lo16(unsigned w) { return __uint_as_float(w << 16); }
__device__ __forceinline__ float hi16(unsigned w) { return __uint_as_float(w & 0xffff0000u); }

struct GmlpArgs { const unsigned short *U, *VG, *Ob, *GWS; const float *LSE, *ln_g, *ln_b, *bs; unsigned short* YC; };

__device__ __forceinline__ void gmlp_phase(LAS unsigned char* lds, LAS float* st, int vcu, int G, const GmlpArgs& A) {
    int tid_ = threadIdx.x; asm volatile("" : "+v"(tid_));
    const int tid = tid_, lane = tid & 63, w = __builtin_amdgcn_readfirstlane(tid >> 6), fr = lane & 15, fq = lane >> 4;
    const lds_cptr L3 = (lds_cptr)lds;
    const int qq = (lane & 15) >> 2, p_ = lane & 3, f8 = qq | ((fq & 1) << 2);
    const int rbase = (8 * fq + qq) * 256 + 64 * p_ + (f8 << 3);
    for (int ci = vcu; ci < 256; ci += G) {
        const int tok0 = ci * 128;
        for (int i = 0; i < 16; ++i) { const int tk = w * 16 + i; const u32x4* rp = (const u32x4*)(A.VG + (size_t)(tok0 + tk) * 1024);
            float v[16];
#pragma unroll
            for (int j = 0; j < 2; ++j) { const u32x4 x = rp[lane + 64 * j];
                v[8 * j + 0] = lo16(x.x); v[8 * j + 1] = hi16(x.x); v[8 * j + 2] = lo16(x.y); v[8 * j + 3] = hi16(x.y); v[8 * j + 4] = lo16(x.z); v[8 * j + 5] = hi16(x.z); v[8 * j + 6] = lo16(x.w); v[8 * j + 7] = hi16(x.w); }
            float s = 0.f;
#pragma unroll
            for (int j = 0; j < 16; ++j) s += v[j];
#pragma unroll
            for (int o = 1; o < 64; o <<= 1) s += __shfl_xor(s, o);
            const float mean = s * (1.0f / 1024.0f); float q = 0.f;
#pragma unroll
            for (int j = 0; j < 16; ++j) { const float d = v[j] - mean; q += d * d; }
#pragma unroll
            for (int o = 1; o < 64; o <<= 1) q += __shfl_xor(q, o);
            if (lane == 0) { st[2 * tk] = mean; st[2 * tk + 1] = 1.0f / sqrtf(q * (1.0f / 1024.0f) + 1e-6f); } }
        __syncthreads();
        u32x4 raw[4];
#define GM_LOAD(g_) do { _Pragma("unroll") for (int i = 0; i < 4; ++i) { const int idx = tid + 512 * i, s = idx >> 4, ch = idx & 15; raw[i] = *(const u32x4*)(A.VG + (size_t)(tok0 + s) * 1024 + 128 * (g_) + 8 * ch); } } while (0)
#define GM_WRITE(g_, buf_) do { _Pragma("unroll") for (int i = 0; i < 4; ++i) { const int idx = tid + 512 * i, s = idx >> 4, ch = idx & 15; const float mean = st[2 * s], rstd = st[2 * s + 1]; \
            const f32x4 g0 = *(const f32x4*)(A.ln_g + 128 * (g_) + 8 * ch), g1 = *(const f32x4*)(A.ln_g + 128 * (g_) + 8 * ch + 4), b0 = *(const f32x4*)(A.ln_b + 128 * (g_) + 8 * ch), b1 = *(const f32x4*)(A.ln_b + 128 * (g_) + 8 * ch + 4); \
            const u32x4 x = raw[i]; \
            const unsigned w0 = cvtpk((lo16(x.x) - mean) * rstd * g0.x + b0.x, (hi16(x.x) - mean) * rstd * g0.y + b0.y), w1 = cvtpk((lo16(x.y) - mean) * rstd * g0.z + b0.z, (hi16(x.y) - mean) * rstd * g0.w + b0.w); \
            const unsigned w2 = cvtpk((lo16(x.z) - mean) * rstd * g1.x + b1.x, (hi16(x.z) - mean) * rstd * g1.y + b1.y), w3 = cvtpk((lo16(x.w) - mean) * rstd * g1.z + b1.z, (hi16(x.w) - mean) * rstd * g1.w + b1.w); \
            const int f = (s & 3) | (((s >> 3) & 1) << 2); const u32x4 o = (f & 1) ? (u32x4){w2, w3, w0, w1} : (u32x4){w0, w1, w2, w3}; \
            *(LAS u32x4*)(lds + (buf_) * 32768 + s * 256 + ((ch ^ (f >> 1)) << 4)) = o; } } while (0)
        bf16x8 wf[4];
#define GM_WS(g_) do { _Pragma("unroll") for (int ks = 0; ks < 4; ++ks) wf[ks] = *(const bf16x8*)(A.GWS + (size_t)(g_) * 16384 + (size_t)(16 * w + fr) * 128 + 32 * ks + 8 * fq); } while (0)
        GM_LOAD(0); GM_WRITE(0, 0);
        __syncthreads();
        for (int g = 0; g < 8; ++g) {
            GM_WS(g);
            if (g < 7) GM_LOAD(g + 1);
            f32x4 acc[8];
#pragma unroll
            for (int n = 0; n < 8; ++n) acc[n] = (f32x4){0.f, 0.f, 0.f, 0.f};
            const int tb = (g & 1) * 32768 + rbase;
#pragma unroll
            for (int ks = 0; ks < 4; ++ks)
#pragma unroll
                for (int n = 0; n < 8; ++n) { const int a0 = (tb ^ (n << 3)) + ks * 8192; const s16x4 x = vtr(L3 + a0), y = vtr(L3 + a0 + 1024);
                    const bf16x8 vf = (bf16x8){x[0], x[1], x[2], x[3], y[0], y[1], y[2], y[3]};
                    acc[n] = __builtin_amdgcn_mfma_f32_16x16x32_bf16(vf, wf[ks], acc[n], 0, 0, 0); }
            { const int t = 16 * w + fr; const size_t tok = (size_t)(tok0 + t); const float bias = A.bs[g * 128 + t];
              const u32x4* up = (const u32x4*)(A.U + tok * 1024 + 128 * g + 32 * fq); u32x4* yp = (u32x4*)(A.YC + tok * 1536 + 128 * g + 32 * fq);
#pragma unroll
              for (int k = 0; k < 4; ++k) { const u32x4 u = up[k]; const f32x4 a = acc[2 * k], b = acc[2 * k + 1]; u32x4 o;
                  o.x = cvtpk(lo16(u.x) * (a.x + bias), hi16(u.x) * (a.y + bias)); o.y = cvtpk(lo16(u.y) * (a.z + bias), hi16(u.y) * (a.w + bias));
                  o.z = cvtpk(lo16(u.z) * (b.x + bias), hi16(u.z) * (b.y + bias)); o.w = cvtpk(lo16(u.w) * (b.z + bias), hi16(u.w) * (b.w + bias)); yp[k] = o; } }
            if (g < 7) GM_WRITE(g + 1, (g + 1) & 1);
            __syncthreads();
        }
#undef GM_LOAD
#undef GM_WRITE
#undef GM_WS
        for (int i = 0; i < 16; ++i) { const int idx = tid + 512 * i, tk = idx >> 6, h = (idx >> 3) & 7, d8 = idx & 7; const int token = tok0 + tk, b = token >> 13, t = token & 8191;
            float ls[3]; u32x4 ov[3];
#pragma unroll
            for (int g = 0; g < 3; ++g) { const int dlog = 2 * g, r = t & ((1 << dlog) - 1), l = t >> dlog; const size_t hr = (size_t)(((g * 4 + b) * 8 + h) * 8192 + r * (8192 >> dlog) + l);
                ov[g] = *(const u32x4*)(A.Ob + hr * 64 + 8 * d8); ls[g] = A.LSE[((size_t)g * 32768 + token) * 8 + h]; }
            const float mx = fmaxf(fmaxf(ls[0], ls[1]), ls[2]); float w0 = __builtin_amdgcn_exp2f(ls[0] - mx), w1 = __builtin_amdgcn_exp2f(ls[1] - mx), w2 = __builtin_amdgcn_exp2f(ls[2] - mx);
            const float inv = 1.0f / (w0 + w1 + w2); w0 *= inv; w1 *= inv; w2 *= inv;
            u32x4 o;
            o.x = cvtpk(w0 * lo16(ov[0].x) + w1 * lo16(ov[1].x) + w2 * lo16(ov[2].x), w0 * hi16(ov[0].x) + w1 * hi16(ov[1].x) + w2 * hi16(ov[2].x));
            o.y = cvtpk(w0 * lo16(ov[0].y) + w1 * lo16(ov[1].y) + w2 * lo16(ov[2].y), w0 * hi16(ov[0].y) + w1 * hi16(ov[1].y) + w2 * hi16(ov[2].y));
            o.z = cvtpk(w0 * lo16(ov[0].z) + w1 * lo16(ov[1].z) + w2 * lo16(ov[2].z), w0 * hi16(ov[0].z) + w1 * hi16(ov[1].z) + w2 * hi16(ov[2].z));
            o.w = cvtpk(w0 * lo16(ov[0].w) + w1 * lo16(ov[1].w) + w2 * lo16(ov[2].w), w0 * hi16(ov[0].w) + w1 * hi16(ov[1].w) + w2 * hi16(ov[2].w));
            *(u32x4*)(A.YC + (size_t)token * 1536 + 1024 + 64 * h + 8 * d8) = o; }
        __syncthreads();
    }
}
}

__device__ __forceinline__ void final_norm(Frame& F, const Args& a) {
    const float* SQ = (const float*)(a.ws + WS_SQ2); const float* g = a.in[14]; float* out = a.out;
    const int gw = F.vcu * NWAVES + F.wave, NGW = F.G * NWAVES;
    f32x4 gv[4];
#pragma unroll
    for (int j = 0; j < 4; ++j) gv[j] = *((const GAS f32x4*)g + F.lane + 64 * j);
    for (int m = gw; m < M; m += NGW) {
        float s = F.lane < 16 ? SQ[(size_t)m * 16 + F.lane] : 0.f; s = wave_sum(s);
        const float rstd = 1.f / sqrtf(s * (1.f / D) + NORM_EPS);
        GAS f32x4* xr = (GAS f32x4*)(out + (size_t)m * D) + F.lane;
#pragma unroll
        for (int j = 0; j < 4; ++j) { const f32x4 v = xr[64 * j]; xr[64 * j] = v * rstd * gv[j]; }
    }
}

__global__ void __launch_bounds__(NWAVES * 64, 2) mk_fwd(Args args) {
    extern __shared__ __attribute__((aligned(16))) unsigned char lds[];
    Frame F;
    F.lds = (LAS unsigned char*)lds;
    F.MISC = (volatile LAS unsigned*)(F.lds + MISC_OFF);
#define REFRAME() do { int t_ = threadIdx.x; asm volatile("" : "+v"(t_)); F.tid = t_; F.lane = t_ & 63; F.wave = __builtin_amdgcn_readfirstlane(t_ >> 6); } while (0)
    REFRAME();
    F.G = gridDim.x; { const int bx = blockIdx.x; F.vcu = (F.G % 8 == 0) ? (bx % 8) * (F.G / 8) + bx / 8 : bx; }
    unsigned char* ws = args.ws;
    F.ctl = (gu32*)(ws + WS_CTL);
    for (int u = F.tid; u < (LDS_BYTES - LDSCTL_OFF) / 4; u += NWAVES * 64) ((LAS unsigned*)(F.lds + LDSCTL_OFF))[u] = 0u;
    __syncthreads();
    XcdBarrier bar; bar.bar = (unsigned*)(F.ctl + CW_BAR); bar.x = 0; bar.st = nullptr;
    if (N_LAUNCHES != PER_PHASE) bar = xcd_barrier_post((unsigned*)(F.ctl + CW_BAR), F.MISC + 8);
#define GRID_BAR() do { if (N_LAUNCHES != PER_PHASE) xcd_barrier(bar); } while (0)
    const int lo = args.ph_lo, hi = args.ph_hi;
#define IN(k) (lo <= (k) && (k) < hi)
#define BOTH(k) (IN(k) && IN((k) + 1))
    bf16* XN = (bf16*)args.out;
    bf16* WIN = (bf16*)(ws + WS_WIN);

    if (IN(0)) {
_Pragma("nounroll") for (int rep = 0; rep < REP_P0; ++rep) { REFRAME(); p0_prologue(F, args); if (BOTH(0)) GRID_BAR(); } }

    if (IN(1))
_Pragma("nounroll") for (int rep = 0; rep < REP_P1; ++rep) {
        pg8::Gemm g{XN, WIN, M, NP1, D}; pg8::StaticOrder S; S.init(M, NP1, F.G, (int)blockIdx.x);
        pg8::EpiProj E{(bf16*)(ws + WS_R)};
        pg8::gemm_phase<pg8::EpiProj, pg8::StaticOrder, true, true>(F.lds + RING_OFF, g, S, E);
        if (BOTH(1)) GRID_BAR();
    }
    if (IN(2)) { att::attn_phase(F.lds + RING_OFF, F.vcu, F.G, (bf16*)(ws + WS_Q), (const bf16*)(ws + WS_K), (const bf16*)(ws + WS_V), (float*)(ws + WS_LSE)); if (BOTH(2)) GRID_BAR(); }
    if (IN(3))
_Pragma("nounroll") for (int rep = 0; rep < REP_P2B; ++rep) { const gm::GmlpArgs GA{(const bf16*)(ws + WS_U), (const bf16*)(ws + WS_VG), (const bf16*)(ws + WS_Q), (const bf16*)(ws + WS_GWS), (const float*)(ws + WS_LSE), args.in[3], args.in[4], args.in[6], (bf16*)(ws + WS_YCAT)};
        gm::gmlp_phase(F.lds + RING_OFF, (LAS float*)(F.lds + RING_BYTES + 1024), F.vcu, F.G, GA); if (BOTH(3)) GRID_BAR(); }
    if (IN(4))
_Pragma("nounroll") for (int rep = 0; rep < REP_P3; ++rep) {
        { pg8::Gemm g{XN, WIN + (size_t)NP1 * D, M, NGATE, D}; pg8::GateOrder S; S.init(M, F.G, (int)blockIdx.x);
          pg8::EpiGate E{(bf16*)(ws + WS_SG)};
          pg8::gemm_phase<pg8::EpiGate, pg8::GateOrder, true, true>(F.lds + RING_OFF, g, S, E); }
        { pg8::Gemm g{(const bf16*)(ws + WS_YCAT), (const bf16*)(ws + WS_WAB), M, D, KCAT}; pg8::StaticOrder S; S.init(M, D, F.G, (int)blockIdx.x);
          pg8::EpiMerge E{(const bf16*)(ws + WS_SG), (bf16*)(ws + WS_MRG)};
          pg8::gemm_phase<pg8::EpiMerge, pg8::StaticOrder, true, true>(F.lds + RING_OFF, g, S, E); }
        if (BOTH(4)) GRID_BAR();
    }
    if (IN(5))
_Pragma("nounroll") for (int rep = 0; rep < REP_P4; ++rep) {
        pg8::Gemm g{(const bf16*)(ws + WS_MRG), (const bf16*)(ws + WS_WOUT), M, D, D}; pg8::StaticOrder S; S.init(M, D, F.G, (int)blockIdx.x);
        pg8::EpiRes1 E{args.in[0], (bf16*)(ws + WS_H1B), (float*)(ws + WS_SQ1)};
        pg8::gemm_phase<pg8::EpiRes1, pg8::StaticOrder, true, true>(F.lds + RING_OFF, g, S, E);
        if (BOTH(5)) GRID_BAR();
    }
    if (IN(6))
_Pragma("nounroll") for (int rep = 0; rep < REP_P5; ++rep) {
        pg8::Gemm g{(const bf16*)(ws + WS_H1B), (const bf16*)(ws + WS_WGU), M, FF2, D}; pg8::StaticOrder S; S.init(M, FF2, F.G, (int)blockIdx.x);
        pg8::EpiSwiglu E{(const float*)(ws + WS_SQ1), (bf16*)(ws + WS_ACT), NORM_EPS};
        pg8::gemm_phase<pg8::EpiSwiglu, pg8::StaticOrder, true, true>(F.lds + RING_OFF, g, S, E);
        if (BOTH(6)) GRID_BAR();
    }
    if (IN(7)) {
        pg8::Gemm g{(const bf16*)(ws + WS_ACT), (const bf16*)(ws + WS_WDN), M, D, FF}; pg8::StaticOrder S; S.init(M, D, F.G, (int)blockIdx.x);
        pg8::EpiRes2 E{(const bf16*)(ws + WS_H1B), args.out, (float*)(ws + WS_SQ2)};
        pg8::gemm_phase<pg8::EpiRes2, pg8::StaticOrder, true, true>(F.lds + RING_OFF, g, S, E);
        if (BOTH(7)) GRID_BAR();
    }
    if (IN(8)) { REFRAME(); final_norm(F, args); }
#undef IN
#undef BOTH
}

extern "C" void kernel_launch(void* const* d_in, const int* in_sizes, int n_in, void* d_out, int out_size, void* d_ws, size_t ws_size, hipStream_t stream) {
    static int grid = 0;
    if (grid == 0) {
        if (n_in != 15 || out_size != M * D || ws_size < WS_END) { fprintf(stderr, "kernel_launch: unexpected shapes: n_in %d out %d ws %zu (need >= %zu)\n", n_in, out_size, ws_size, (size_t)WS_END); grid = -1; return; }
        int dev = 0, cus = 0, per_cu = 0;
        if (hipGetDevice(&dev) != hipSuccess || hipDeviceGetAttribute(&cus, hipDeviceAttributeMultiprocessorCount, dev) != hipSuccess) { grid = -1; return; }
        if (hipFuncSetAttribute((const void*)mk_fwd, hipFuncAttributeMaxDynamicSharedMemorySize, LDS_BYTES) != hipSuccess) { fprintf(stderr, "kernel_launch: hipFuncSetAttribute failed\n"); grid = -1; return; }
        if (hipOccupancyMaxActiveBlocksPerMultiprocessor(&per_cu, (const void*)mk_fwd, NWAVES * 64, LDS_BYTES) != hipSuccess || per_cu < 1)
            fprintf(stderr, "kernel_launch: occupancy query reports %d workgroups per CU\n", per_cu);
        (void)hipGetLastError();
        grid = cus;
    }
    if (grid < 0) return;
    if (hipMemsetAsync((char*)d_ws + WS_CTL, 0, CTL_ZERO_BYTES, stream) != hipSuccess) { fprintf(stderr, "kernel_launch: hipMemsetAsync failed\n"); return; }
    Args a{};
    for (int i = 0; i < 15; ++i) a.in[i] = (const float*)d_in[i];
    a.out = (float*)d_out; a.ws = (unsigned char*)d_ws;
    for (int li = 0; li < N_LAUNCHES; ++li) {
        a.ph_lo = (N_LAUNCHES == PER_PHASE) ? li : 0; a.ph_hi = (N_LAUNCHES == PER_PHASE) ? li + 1 : PER_PHASE;
        hipLaunchKernelGGL(mk_fwd, dim3(grid), dim3(NWAVES * 64), LDS_BYTES, stream, a);
        const hipError_t le = hipPeekAtLastError();
        if (le != hipSuccess) { fprintf(stderr, "kernel_launch: launch %d failed: %s\n", li, hipGetErrorName(le)); break; }
    }
}
```
